# Optimizing an MI355X kernel written in HIP

```python
import math
import jax, jax.numpy as jnp
from jax import lax
import numpy as np

D_MODEL = 1024
BATCH = 4
SEQ = 8192
DEPTH = 4

N_META = 16
MLA_HEADS = 8
Q_LORA = 384
KV_LORA = 256
QK_NOPE = 64
QK_ROPE = 32
V_HEAD = 64
ROPE_THETA = 10000.0
Q_BLOCK = 128
HG_HEADS = 4
HG_KDIM = 128
HG_VDIM = 128
HG_CHUNK = 64
D_FF = 2816
EPS = 1e-6
NEG_BIG = -1e30
F_MIN = 1e-20

MLA_WIDTH = MLA_HEADS * V_HEAD
HG_FWIDTH = HG_HEADS * HG_KDIM
HG_WIDTH = HG_HEADS * HG_VDIM
IN_SPLITS = (Q_LORA, KV_LORA, QK_ROPE, HG_FWIDTH, HG_FWIDTH, HG_WIDTH, HG_WIDTH, D_MODEL, D_MODEL)
D_IN = sum(IN_SPLITS)

kernel_name = "hybrid_mla_hgrn2_macaron_meta"


def rms_norm(x, w):
    xf = x.astype(jnp.float32)
    y = xf * lax.rsqrt(jnp.mean(xf * xf, axis=-1, keepdims=True) + EPS)
    return (y * w.astype(jnp.float32)).astype(x.dtype)


def split_cols(z, sizes):
    outs, start = [], 0
    for s in sizes:
        outs.append(z[..., start:start + s])
        start += s
    return outs


def swiglu(x, w_gu, w_down):
    gate, up = jnp.split(x @ w_gu, 2, axis=-1)
    return (jax.nn.silu(gate) * up) @ w_down


def rope(x, pos):
    half = x.shape[-1] // 2
    inv = ROPE_THETA ** (-jnp.arange(half, dtype=jnp.float32) / half)
    ang = pos.astype(jnp.float32)[:, None] * inv[None, :]
    cos = jnp.cos(ang)[:, None, :]
    sin = jnp.sin(ang)[:, None, :]
    x1 = x[..., :half].astype(jnp.float32)
    x2 = x[..., half:].astype(jnp.float32)
    return jnp.concatenate([x1 * cos - x2 * sin, x2 * cos + x1 * sin], axis=-1).astype(x.dtype)


def mla(c_q, c_kv, k_pe, pos, q_norm_w, kv_norm_w, w_uq, w_ukv):
    B, L, _ = c_q.shape
    H, DQK = MLA_HEADS, QK_NOPE + QK_ROPE
    q = (rms_norm(c_q, q_norm_w) @ w_uq).reshape(B, L, H, DQK)
    q = jnp.concatenate([q[..., :QK_NOPE], rope(q[..., QK_NOPE:], pos)], axis=-1)
    kv = (rms_norm(c_kv, kv_norm_w) @ w_ukv).reshape(B, L, H, QK_NOPE + V_HEAD)
    v = kv[..., QK_NOPE:]
    k_rot = rope(k_pe[:, :, None, :], pos)
    k = jnp.concatenate([kv[..., :QK_NOPE], jnp.broadcast_to(k_rot, (B, L, H, QK_ROPE))], axis=-1)
    scale = DQK ** -0.5
    n_blocks = -(-L // Q_BLOCK)
    pad = n_blocks * Q_BLOCK - L
    qb = jnp.pad(q, ((0, 0), (0, pad), (0, 0), (0, 0)))
    qb = qb.reshape(B, n_blocks, Q_BLOCK, H, DQK).transpose(1, 0, 2, 3, 4)
    k_pos = jnp.arange(L)

    def block(args):
        qi, blk = args
        s = jnp.einsum('bqhd,bkhd->bhqk', qi, k).astype(jnp.float32) * scale
        q_pos = blk * Q_BLOCK + jnp.arange(Q_BLOCK)
        s = jnp.where(k_pos[None, :] <= q_pos[:, None], s, NEG_BIG)
        p = jax.nn.softmax(s, axis=-1).astype(v.dtype)
        return jnp.einsum('bhqk,bkhd->bqhd', p, v)

    o = lax.map(block, (qb, jnp.arange(n_blocks)))
    o = o.transpose(1, 0, 2, 3, 4).reshape(B, n_blocks * Q_BLOCK, H * V_HEAD)
    return o[:, :L]


def hgrn2(q_in, f_in, i_in, g_in, lb, norm_w):
    B, L, _ = q_in.shape
    dt = q_in.dtype
    f32 = jnp.float32
    q = jax.nn.silu(q_in.astype(f32)).reshape(B, L, HG_HEADS, HG_KDIM)
    z = f_in.astype(f32).reshape(B, L, HG_HEADS, HG_KDIM)
    lbf = lb.astype(f32).reshape(HG_HEADS, HG_KDIM)
    f = lbf + (1.0 - lbf) * jax.nn.sigmoid(z)
    log_f = jnp.log(jnp.maximum(f, F_MIN))
    k = (1.0 - lbf) * jax.nn.sigmoid(-z)
    v = i_in.astype(f32).reshape(B, L, HG_HEADS, HG_VDIM)
    front = (-N_META) % HG_CHUNK

    def to_chunks(t):
        t = jnp.pad(t, ((0, 0), (front, 0), (0, 0), (0, 0)))
        n = t.shape[1] // HG_CHUNK
        return t.reshape(B, n, HG_CHUNK, HG_HEADS, t.shape[-1]).transpose(1, 0, 3, 2, 4)

    qc, kc, vc, gc = to_chunks(q), to_chunks(k), to_chunks(v), to_chunks(log_f)
    scale = HG_KDIM ** -0.5
    causal = jnp.tril(jnp.ones((HG_CHUNK, HG_CHUNK), dtype=bool))

    def step(S, inp):
        qt, kt, vt, gt = inp
        b = jnp.cumsum(gt, axis=2)
        diff = b[:, :, :, None, :] - b[:, :, None, :, :]
        decay = jnp.exp(jnp.where(causal[:, :, None], diff, NEG_BIG))
        attn = jnp.einsum('bhtk,bhtsk,bhsk->bhts', qt, decay, kt) * scale
        o = jnp.einsum('bhts,bhsv->bhtv', attn, vt) + \
            jnp.einsum('bhtk,bhkv->bhtv', qt * jnp.exp(b) * scale, S)
        b_last = b[:, :, -1:, :]
        S = jnp.exp(b_last[:, :, 0, :])[..., None] * S + \
            jnp.einsum('bhsk,bhsv->bhkv', kt * jnp.exp(b_last - b), vt)
        return S, o

    S0 = jnp.zeros((B, HG_HEADS, HG_KDIM, HG_VDIM), f32)
    _, o = lax.scan(step, S0, (qc, kc, vc, gc))
    n = o.shape[0]
    o = o.transpose(1, 0, 3, 2, 4).reshape(B, n * HG_CHUNK, HG_HEADS, HG_VDIM)[:, front:]
    o = o * lax.rsqrt(jnp.mean(o * o, axis=-1, keepdims=True) + EPS) * norm_w.astype(f32)
    gate = jax.nn.silu(g_in.astype(f32)).reshape(B, L, HG_HEADS, HG_VDIM)
    return (o * gate).reshape(B, L, HG_WIDTH).astype(dt)


def setup_inputs(seed: int = 0) -> dict:
    key = jax.random.key(seed)
    ks = jax.random.split(key, 24)
    f32 = jnp.float32

    def nrm(k, shape, fan_in):
        return jax.random.normal(k, shape, f32) * (fan_in ** -0.5)

    def gain(k, shape):
        return 1.0 + 0.02 * jax.random.normal(k, shape, f32)

    return {
        "x": jax.random.normal(ks[0], (BATCH, SEQ, D_MODEL), f32),
        "meta_tokens": jax.random.normal(ks[1], (N_META, D_MODEL), f32),
        "ffn1_norm": gain(ks[2], (DEPTH, D_MODEL)),
        "ffn1_w_gu": nrm(ks[3], (DEPTH, D_MODEL, 2 * D_FF), D_MODEL),
        "ffn1_w_down": nrm(ks[4], (DEPTH, D_FF, D_MODEL), D_FF),
        "mix_norm": gain(ks[5], (DEPTH, D_MODEL)),
        "w_in": nrm(ks[6], (DEPTH, D_MODEL, D_IN), D_MODEL),
        "q_norm": gain(ks[7], (DEPTH, Q_LORA)),
        "kv_norm": gain(ks[8], (DEPTH, KV_LORA)),
        "w_uq": nrm(ks[9], (DEPTH, Q_LORA, MLA_HEADS * (QK_NOPE + QK_ROPE)), Q_LORA),
        "w_ukv": nrm(ks[10], (DEPTH, KV_LORA, MLA_HEADS * (QK_NOPE + V_HEAD)), KV_LORA),
        "hg_lb_raw": 0.5 * jax.random.normal(ks[11], (DEPTH, HG_FWIDTH), f32),
        "hg_norm": gain(ks[12], (DEPTH, HG_VDIM)),
        "w_proj_attn": nrm(ks[13], (DEPTH, MLA_WIDTH, D_MODEL), MLA_WIDTH),
        "w_proj_rec": nrm(ks[14], (DEPTH, HG_WIDTH, D_MODEL), HG_WIDTH),
        "w_out": nrm(ks[15], (DEPTH, D_MODEL, D_MODEL), D_MODEL),
        "ffn2_norm": gain(ks[16], (DEPTH, D_MODEL)),
        "ffn2_w_gu": nrm(ks[17], (DEPTH, D_MODEL, 2 * D_FF), D_MODEL),
        "ffn2_w_down": nrm(ks[18], (DEPTH, D_FF, D_MODEL), D_FF),
        "final_norm": gain(ks[19], (D_MODEL,)),
    }


def reference(x, meta_tokens, ffn1_norm, ffn1_w_gu, ffn1_w_down, mix_norm, w_in, q_norm, kv_norm,
              w_uq, w_ukv, hg_lb_raw, hg_norm, w_proj_attn, w_proj_rec, w_out,
              ffn2_norm, ffn2_w_gu, ffn2_w_down, final_norm):
    B = x.shape[0]
    meta = jnp.broadcast_to(meta_tokens.astype(x.dtype)[None], (B, N_META, D_MODEL))
    h = jnp.concatenate([meta, x], axis=1)
    L = h.shape[1]
    pos = jnp.arange(L)
    p_lb = jax.nn.softmax(hg_lb_raw.astype(jnp.float32), axis=0)
    lbs = jnp.cumsum(p_lb, axis=0) - p_lb[0:1]
    for l in range(DEPTH):
        h = h + 0.5 * swiglu(rms_norm(h, ffn1_norm[l]), ffn1_w_gu[l], ffn1_w_down[l])
        u = rms_norm(h, mix_norm[l])
        c_q, c_kv, k_pe, hq, hf, hi, hg, ga, gb = split_cols(u @ w_in[l], IN_SPLITS)
        y_a = mla(c_q, c_kv, k_pe, pos, q_norm[l], kv_norm[l], w_uq[l], w_ukv[l]) @ w_proj_attn[l]
        y_b = hgrn2(hq, hf, hi, hg, lbs[l], hg_norm[l]) @ w_proj_rec[l]
        merged = jax.nn.sigmoid(ga) * y_a + jax.nn.sigmoid(gb) * y_b
        h = h + merged @ w_out[l]
        h = h + 0.5 * swiglu(rms_norm(h, ffn2_norm[l]), ffn2_w_gu[l], ffn2_w_down[l])
    return rms_norm(h, final_norm)[:, N_META:]
```

```cpp
#include <hip/hip_runtime.h>
#include <hip/hip_cooperative_groups.h>
#include <cstdio>
#include <cstdint>
namespace cg = cooperative_groups;
__device__ __forceinline__ int bid() { int b = (int)__builtin_amdgcn_workgroup_id_x(); asm volatile("" : "+s"(b)); return b; }
__device__ __forceinline__ int lane_id_() { int l; asm volatile("v_mbcnt_lo_u32_b32 %0, -1, 0\n\tv_mbcnt_hi_u32_b32 %0, -1, %0" : "=v"(l)); return l; }
#define TIDX ((wv_ << 6) | lane_id_())
__device__ __forceinline__ int lnd(int l) { asm volatile("" : "+s"(l)); return l; }
__device__ __forceinline__ int gdim() { int g = (int)(__builtin_amdgcn_grid_size_x() / 512u); asm volatile("" : "+s"(g)); return g; }

constexpr int DM = 1024, NBATCH = 4, SEQ = 8192, DEPTH = 4, NMETA = 16;
constexpr int FRONT = 48, LP = 8256  , MROWS = NBATCH * LP  ;
constexpr int DFF = 2816, DIN = 4768, NCH = LP / 64  ;
constexpr float EPS = 1e-6f;
constexpr float C2Q = 0.10206207261596575f * 1.4426950408889634f;
constexpr float HG_SCALE = 0.08838834764831845f;

namespace pg8 {
#define PG8_LAS __attribute__((address_space(3)))
typedef unsigned short bf16_t;
typedef short bf16x8 __attribute__((ext_vector_type(8)));
typedef float f32x4 __attribute__((ext_vector_type(4)));
typedef unsigned u32x4 __attribute__((ext_vector_type(4)));
constexpr int BM = 256, BK = 64, HALF = 128, HTB = HALF * BK * 2  , STAGE_BYTES = 8 * HTB, NXCD = 8, WGM = 8;
__host__ __device__ __forceinline__ int lds_byte(int r, int c) { const int st = (r >> 4) * 2 + (c >> 5), rr = r & 15, cc = c & 31, ob = rr * 64 + cc * 2; return st * 1024 + (ob ^ (((ob >> 9) & 1) << 5)); }
__host__ __device__ __forceinline__ void stage_rc(int b, int& R, int& C) { const int st = b / 1024, sb = b % 1024, swz = sb ^ (((sb >> 9) & 1) << 5); R = (st >> 1) * 16 + swz / 64; C = (st & 1) * 32 + (swz % 64) / 2; }
__host__ __device__ __forceinline__ int perm32(int rho) { const int n = rho >> 4, i = rho & 15; return 8 * (i >> 2) + 4 * n + (i & 3); }
struct Unit { int pm, pn; };
struct Gemm { const bf16_t* A; const bf16_t* Bt; int lda, ldb; int M, N, K; };
struct StaticOrder {
    int nM, nN, nwg, G, c;
    __host__ __device__ void init(int M, int N, int G_, int c_) { nM = M / BM; nN = N / BM; nwg = nM * nN; G = G_; c = c_; }
    __host__ __device__ bool next(int i, Unit& u) const {
        const long L = (long)i * G + c; if (L >= nwg) return false;
        int wgid = (int)L; { const int q = nwg / NXCD, r = nwg % NXCD, xcd = wgid % NXCD, off = wgid / NXCD; wgid = (xcd < r ? xcd * (q + 1) : r * (q + 1) + (xcd - r) * q) + off; }
        const int nig = WGM * nN, gid = wgid / nig, fm = gid * WGM, gsz = (nM - fm) < WGM ? (nM - fm) : WGM;
        u.pm = fm + ((wgid % nig) % gsz); u.pn = (wgid % nig) / gsz; return true;
    }
    __device__ __forceinline__ void a_ready(const Unit&) const {}
    __device__ __forceinline__ void done(const Unit&) const {}
};
typedef float f32x2_t __attribute__((ext_vector_type(2))); typedef __bf16 bf16x2_t __attribute__((ext_vector_type(2)));
__device__ __forceinline__ unsigned cvt_pk_bf16(float lo, float hi) { f32x2_t v = {lo, hi}; bf16x2_t b = __builtin_convertvector(v, bf16x2_t); return __builtin_bit_cast(unsigned, b); }
__device__ __forceinline__ float bf2f(unsigned short b) { return __uint_as_float((unsigned)b << 16); }
__device__ __forceinline__ float bflo(unsigned w) { return __uint_as_float(w << 16); }
__device__ __forceinline__ float bfhi(unsigned w) { return __uint_as_float(w & 0xffff0000u); }
__device__ __forceinline__ float sigmoidf_(float x) { return __builtin_amdgcn_rcpf(1.f + __builtin_amdgcn_exp2f(-1.4426950408889634f * x)); }
__device__ __forceinline__ float siluf_(float x) { return x * sigmoidf_(x); }
__device__ __forceinline__ float hsum4(f32x4 a) { return (a[0] + a[1]) + (a[2] + a[3]); }
__device__ __forceinline__ float rstd16(const float* ssq, int row) {
    const f32x4* p = (const f32x4*)(ssq + (size_t)row * 16); const f32x4 a = p[0], b = p[1], c = p[2], d = p[3];
    const float s = (hsum4(a) + hsum4(b)) + (hsum4(c) + hsum4(d)); return rsqrtf(s * (1.f / 1024.f) + EPS);
}
__device__ __forceinline__ u32x4 pack8(f32x4 v0, f32x4 v1) { u32x4 w; w.x = cvt_pk_bf16(v0[0], v0[1]); w.y = cvt_pk_bf16(v0[2], v0[3]); w.z = cvt_pk_bf16(v1[0], v1[1]); w.w = cvt_pk_bf16(v1[2], v1[3]); return w; }
#define EPI_SIG (const f32x4 (&acc)[2][2][4][2], const Unit& u, int wr, int wc, int fr, int fq) const
#define EPI_ROWS _Pragma("unroll") for (int ai = 0; ai < 2; ++ai) _Pragma("unroll") for (int m = 0; m < 4; ++m)
#define EPI_ROW (u.pm * BM + ai * HALF + wr * 64 + m * 16 + fr)

struct EpiFfnUp { static constexpr bool PERM = true, AFTER_DRAIN = false; bf16_t* H; const float* ssq;
    __device__ __forceinline__ void operator() EPI_SIG {
        const int colo = u.pn * 128 + wc * 32 + 8 * fq;
        EPI_ROWS { const int row = EPI_ROW; const float rs = rstd16(ssq, row);
            f32x4 o[2];
#pragma unroll
            for (int n = 0; n < 2; ++n) { const f32x4 g = acc[ai][0][m][n] * rs, up = acc[ai][1][m][n] * rs;
#pragma unroll
                for (int e = 0; e < 4; ++e) o[n][e] = siluf_(g[e]) * up[e]; }
            *(u32x4*)(H + (size_t)row * DFF + colo) = pack8(o[0], o[1]); asm volatile("" ::: "memory"); }
    }
};
struct EpiResid { static constexpr bool PERM = true, AFTER_DRAIN = false; bf16_t* hb; float* ssq; float alpha; int maskpad;
    __device__ __forceinline__ void operator() EPI_SIG {
        EPI_ROWS { const int row = EPI_ROW; const bool pad = maskpad && ((row % LP) < FRONT); float s = 0.f;
#pragma unroll
            for (int bj = 0; bj < 2; ++bj) { const int col0 = u.pn * BM + bj * HALF + wc * 32 + 8 * fq; bf16_t* hp = hb + (size_t)row * DM + col0;
                const u32x4 hw = *(const u32x4*)hp;
                f32x4 a0 = {bflo(hw.x), bfhi(hw.x), bflo(hw.y), bfhi(hw.y)}, a1 = {bflo(hw.z), bfhi(hw.z), bflo(hw.w), bfhi(hw.w)};
                a0 = a0 + acc[ai][bj][m][0] * alpha; a1 = a1 + acc[ai][bj][m][1] * alpha;
                if (pad) { a0 = (f32x4){0.f, 0.f, 0.f, 0.f}; a1 = a0; }
                *(u32x4*)hp = pack8(a0, a1);
                s += hsum4(a0 * a0) + hsum4(a1 * a1); }
            s += __shfl_xor(s, 16); s += __shfl_xor(s, 32);
            if (fq == 0) ssq[(size_t)row * 16 + u.pn * 4 + wc] = s; asm volatile("" ::: "memory"); }
    }
};
struct EpiWin1 { static constexpr bool PERM = true, AFTER_DRAIN = false; bf16_t* zc; bf16_t* hg4; bf16_t* G; const float* ssq; float* ssq2;
    __device__ __forceinline__ void operator() EPI_SIG {
        EPI_ROWS { const int row = EPI_ROW; const float rs = rstd16(ssq, row);
#pragma unroll
            for (int bj = 0; bj < 2; ++bj) { const int col0 = u.pn * BM + bj * HALF + wc * 32 + 8 * fq;
                const f32x4 v0 = acc[ai][bj][m][0] * rs, v1 = acc[ai][bj][m][1] * rs; const u32x4 w = pack8(v0, v1);
                if (u.pn < 3) { *(u32x4*)(zc + (size_t)row * 768 + col0) = w;
                    float s = hsum4(v0 * v0) + hsum4(v1 * v1); s += __shfl_xor(s, 16); s += __shfl_xor(s, 32);
                    if (fq == 0) ssq2[(size_t)row * 24 + (u.pn * 2 + bj) * 4 + wc] = s; }
                else if (u.pn < 11) *(u32x4*)(hg4 + (size_t)row * 2048 + (col0 - 768)) = w;
                else { f32x4 g0, g1;
#pragma unroll
                    for (int e = 0; e < 4; ++e) { g0[e] = sigmoidf_(v0[e]); g1[e] = sigmoidf_(v1[e]); }
                    *(u32x4*)(G + (size_t)row * 2048 + (col0 - 2816)) = pack8(g0, g1); } } asm volatile("" ::: "memory"); }
    }
};
struct EpiQ { static constexpr bool PERM = true, AFTER_DRAIN = false; bf16_t* q; const float* ssq2; const float* rope;
    __device__ __forceinline__ void operator() EPI_SIG {
        EPI_ROWS { const int row = EPI_ROW; const int p = row % LP;
            const f32x4* sp = (const f32x4*)(ssq2 + (size_t)row * 24); const float ss = hsum4(sp[0]) + hsum4(sp[1]) + hsum4(sp[2]);
            const float rs = rsqrtf(ss * (1.f / 384.f) + EPS);
#pragma unroll
            for (int bj = 0; bj < 2; ++bj) { const int g = u.pn * 8 + bj * 4 + wc; const int col0 = u.pn * BM + bj * HALF + wc * 32 + 8 * fq;
                f32x4 v0 = acc[ai][bj][m][0] * rs, v1 = acc[ai][bj][m][1] * rs;
                if (g % 3 == 2) { const f32x4* rp = (const f32x4*)(rope + ((size_t)p * 16 + 8 * (fq & 1)) * 2); const bool lo = fq < 2;
#pragma unroll
                    for (int e2 = 0; e2 < 4; ++e2) { const f32x4 cs = rp[e2];
#pragma unroll
                        for (int k = 0; k < 2; ++k) { const int e = 2 * e2 + k; const float mine = e < 4 ? v0[e & 3] : v1[e & 3]; const float oth = __shfl_xor(mine, 32);
                            const float c = cs[2 * k], sn = cs[2 * k + 1]; const float r = lo ? (mine * c - oth * sn) : (mine * c + oth * sn);
                            if (e < 4) v0[e & 3] = r; else v1[e & 3] = r; } } }
                v0 = v0 * C2Q; v1 = v1 * C2Q; *(u32x4*)(q + (size_t)row * 768 + col0) = pack8(v0, v1); } asm volatile("" ::: "memory"); }
    }
};
struct EpiKn { static constexpr bool PERM = true, AFTER_DRAIN = false; bf16_t* kn; const float* ssq2;
    __device__ __forceinline__ void operator() EPI_SIG {
        EPI_ROWS { const int row = EPI_ROW; const f32x4* sp = (const f32x4*)(ssq2 + (size_t)row * 24 + 12); const float rs = rsqrtf((hsum4(sp[0]) + hsum4(sp[1])) * (1.f / 256.f) + EPS);
#pragma unroll
            for (int bj = 0; bj < 2; ++bj) { const int col0 = u.pn * BM + bj * HALF + wc * 32 + 8 * fq;
                *(u32x4*)(kn + (size_t)row * 512 + col0) = pack8(acc[ai][bj][m][0] * rs, acc[ai][bj][m][1] * rs); } asm volatile("" ::: "memory"); }
    }
};
struct EpiVt { static constexpr bool PERM = true, AFTER_DRAIN = false; bf16_t* vt; const float* ssq2;
    __device__ __forceinline__ void operator() EPI_SIG {
#pragma unroll
        for (int bj = 0; bj < 2; ++bj) { const int col0 = u.pn * BM + bj * HALF + wc * 32 + 8 * fq; f32x4 rs0, rs1;
#pragma unroll
            for (int e = 0; e < 8; ++e) { const f32x4* sp = (const f32x4*)(ssq2 + (size_t)(col0 + e) * 24 + 12); const float r = rsqrtf((hsum4(sp[0]) + hsum4(sp[1])) * (1.f / 256.f) + EPS);
                if (e < 4) rs0[e & 3] = r; else rs1[e & 3] = r; if (e & 1) asm volatile("" ::: "memory"); }
            EPI_ROWS { const int row = EPI_ROW; *(u32x4*)(vt + (size_t)row * MROWS + col0) = pack8(acc[ai][bj][m][0] * rs0, acc[ai][bj][m][1] * rs1); asm volatile("" ::: "memory"); } }
    }
};
struct EpiGate { static constexpr bool PERM = true, AFTER_DRAIN = false; bf16_t* G; const float* ssq;
    __device__ __forceinline__ void operator() EPI_SIG {
        EPI_ROWS { const int row = EPI_ROW; const float rs = rstd16(ssq, row);
#pragma unroll
            for (int bj = 0; bj < 2; ++bj) { const int col0 = u.pn * BM + bj * HALF + wc * 32 + 8 * fq; f32x4 o[2];
#pragma unroll
                for (int n = 0; n < 2; ++n) { const f32x4 v = acc[ai][bj][m][n] * rs;
#pragma unroll
                    for (int e = 0; e < 4; ++e) o[n][e] = sigmoidf_(v[e]); }
                *(u32x4*)(G + (size_t)row * 2048 + col0) = pack8(o[0], o[1]); } asm volatile("" ::: "memory"); }
    }
};
struct EpiMerge { static constexpr bool PERM = true, AFTER_DRAIN = false; bf16_t* mg; const bf16_t* G;
    __device__ __forceinline__ void operator() EPI_SIG {
        const int colo = u.pn * 128 + wc * 32 + 8 * fq;
        EPI_ROWS { const int row = EPI_ROW; const u32x4 ga = *(const u32x4*)(G + (size_t)row * 2048 + colo), gb = *(const u32x4*)(G + (size_t)row * 2048 + 1024 + colo);
            f32x4 o0, o1; const f32x4 a0 = acc[ai][0][m][0], a1 = acc[ai][0][m][1], b0 = acc[ai][1][m][0], b1 = acc[ai][1][m][1];
            o0[0] = bflo(ga.x) * a0[0] + bflo(gb.x) * b0[0]; o0[1] = bfhi(ga.x) * a0[1] + bfhi(gb.x) * b0[1];
            o0[2] = bflo(ga.y) * a0[2] + bflo(gb.y) * b0[2]; o0[3] = bfhi(ga.y) * a0[3] + bfhi(gb.y) * b0[3];
            o1[0] = bflo(ga.z) * a1[0] + bflo(gb.z) * b1[0]; o1[1] = bfhi(ga.z) * a1[1] + bfhi(gb.z) * b1[1];
            o1[2] = bflo(ga.w) * a1[2] + bflo(gb.w) * b1[2]; o1[3] = bfhi(ga.w) * a1[3] + bfhi(gb.w) * b1[3];
            *(u32x4*)(mg + (size_t)row * DM + colo) = pack8(o0, o1); asm volatile("" ::: "memory"); }
    }
};
template <class Epi, class Sched, bool ALIGN_EPI = false, bool SP2 = false>
__device__ __forceinline__ void gemm_phase(PG8_LAS unsigned char* lds, const Gemm g, const Sched& S, const Epi& E, int wv_) {
    int tid_ = TIDX; asm volatile("" : "+v"(tid_)); const int tid = tid_, wid = wv_, lane = tid & 63, wr = wid >> 2, wc = wid & 3, fr = lane & 15, fq = lane >> 4;
    const int K = g.K, nt = K / BK;
    unsigned voffA[2], voffB[2];
#pragma unroll
    for (int i = 0; i < 2; ++i) { int R, C; stage_rc(tid * 16 + i * 8192, R, C); const int Rb = Epi::PERM ? ((R & ~31) + perm32(R & 31)) : R;
        voffA[i] = (unsigned)(R * g.lda + C) * 2u; voffB[i] = (unsigned)(Rb * g.ldb + C) * 2u; }
    const size_t kstep = (size_t)(BK * 2);
    const size_t hstepA = (size_t)HALF * g.lda * 2, hstepB = (size_t)HALF * g.ldb * 2;
    const size_t tstepA = 2 * hstepA, tstepB = 2 * hstepB;
    const unsigned ldsw = (unsigned)wid * 1024u;
    const int aoff = lds_byte(wr * 64 + fr, fq * 8), boff = lds_byte(wc * 32 + fr, fq * 8);
#define PG8_SA(b, h) (((b) * 2 + (h)) * HTB)
#define PG8_SB(b, h) ((4 + (b) * 2 + (h)) * HTB)
#define PG8_STAGE(bufoff, gbase, voff) do { _Pragma("unroll") for (int _i = 0; _i < 2; ++_i) \
        __builtin_amdgcn_global_load_lds((const unsigned*)((const char*)(gbase) + (voff)[_i]), (PG8_LAS unsigned*)(lds + (bufoff) + ldsw + _i * 8192), 16, 0, 0); } while (0)
#define PG8_LDA(dst, b, h) do { _Pragma("unroll") for (int m = 0; m < 4; ++m) _Pragma("unroll") for (int k = 0; k < 2; ++k) dst[m][k] = *(const PG8_LAS bf16x8*)(lds + PG8_SA(b, h) + aoff + m * 2048 + k * 1024); } while (0)
#define PG8_LDB(dst, b, h) do { _Pragma("unroll") for (int n = 0; n < 2; ++n) _Pragma("unroll") for (int k = 0; k < 2; ++k) dst[n][k] = *(const PG8_LAS bf16x8*)(lds + PG8_SB(b, h) + boff + n * 2048 + k * 1024); } while (0)
#define PG8_MMA(ai, bj, At, Bt) do { __builtin_amdgcn_s_setprio(1); _Pragma("unroll") for (int m = 0; m < 4; ++m) _Pragma("unroll") for (int n = 0; n < 2; ++n) _Pragma("unroll") for (int k = 0; k < 2; ++k) \
        acc[ai][bj][m][n] = __builtin_amdgcn_mfma_f32_16x16x32_bf16(Bt[n][k], At[m][k], acc[ai][bj][m][n], 0, 0, 0); __builtin_amdgcn_s_setprio(0); } while (0)
#define PG8_WAIT_V(n) asm volatile("s_waitcnt vmcnt(" #n ")" ::: "memory")
#define PG8_WAIT_L(n) asm volatile("s_waitcnt lgkmcnt(" #n ")" ::: "memory")
#define PG8_BAR __builtin_amdgcn_s_barrier()
#define PG8_SCHED __builtin_amdgcn_sched_barrier(0)
    Unit cur, nxt; int ui = 0;
    if (!S.next(0, cur)) return;
    f32x4 acc[2][2][4][2];
#pragma unroll
    for (int a = 0; a < 2; ++a)
#pragma unroll
        for (int b = 0; b < 2; ++b)
#pragma unroll
            for (int m = 0; m < 4; ++m)
#pragma unroll
                for (int n = 0; n < 2; ++n) acc[a][b][m][n] = (f32x4){0.f, 0.f, 0.f, 0.f};
    bf16x8 At[4][2], B0[2][2], B1[2][2];
    const char* cA = (const char*)g.A + (size_t)cur.pm * tstepA; const char* cB = (const char*)g.Bt + (size_t)cur.pn * tstepB;
    S.a_ready(cur);
    if constexpr (SP2) {
        PG8_STAGE(PG8_SB(0, 0), cB, voffB); PG8_STAGE(PG8_SB(0, 1), cB + hstepB, voffB); PG8_STAGE(PG8_SA(0, 0), cA, voffA); PG8_STAGE(PG8_SA(0, 1), cA + hstepA, voffA);
        if (wr == 1) PG8_BAR;
        PG8_WAIT_V(2); PG8_BAR;
        PG8_STAGE(PG8_SB(1, 0), cB + kstep, voffB); PG8_STAGE(PG8_SA(1, 0), cA + kstep, voffA); PG8_STAGE(PG8_SB(1, 1), cB + hstepB + kstep, voffB);
        PG8_WAIT_V(6); PG8_BAR;
    } else {
        PG8_STAGE(PG8_SB(0, 0), cB, voffB); PG8_STAGE(PG8_SA(0, 0), cA, voffA); PG8_STAGE(PG8_SB(0, 1), cB + hstepB, voffB); PG8_STAGE(PG8_SA(0, 1), cA + hstepA, voffA);
        if (wr == 1) PG8_BAR;
        PG8_WAIT_V(4); PG8_BAR;
        PG8_STAGE(PG8_SB(1, 0), cB + kstep, voffB); PG8_STAGE(PG8_SA(1, 0), cA + kstep, voffA); PG8_STAGE(PG8_SB(1, 1), cB + hstepB + kstep, voffB);
        PG8_WAIT_V(6); PG8_BAR;
    }
    for (;;) {
        const bool has_next = S.next(ui + 1, nxt);
        const char* nA = has_next ? (const char*)g.A + (size_t)nxt.pm * tstepA : cA; const char* nB = has_next ? (const char*)g.Bt + (size_t)nxt.pn * tstepB : cB;
        for (int t = 0; t < nt; t += 2) {
            const bool last = (t == nt - 2);
            const char* a1 = cA + (size_t)(t + 1) * kstep;
            const char* a2 = last ? nA : cA + (size_t)(t + 2) * kstep; const char* b2 = last ? nB : cB + (size_t)(t + 2) * kstep;
            const char* a3 = a2 + kstep; const char* b3 = b2 + kstep;
            if (last && has_next) S.a_ready(nxt);
            if constexpr (SP2) {
            PG8_LDB(B0, 0, 0); PG8_LDB(B1, 0, 1); PG8_SCHED; PG8_LDA(At, 0, 0); PG8_STAGE(PG8_SA(1, 1), a1 + hstepA, voffA);
            PG8_WAIT_V(8); PG8_WAIT_L(0); PG8_BAR; PG8_MMA(0, 0, At, B0); PG8_MMA(0, 1, At, B1); PG8_BAR; PG8_SCHED;
            PG8_LDA(At, 0, 1); PG8_STAGE(PG8_SB(0, 0), b2, voffB); PG8_STAGE(PG8_SB(0, 1), b2 + hstepB, voffB); PG8_STAGE(PG8_SA(0, 0), a2, voffA);
            PG8_WAIT_V(8); PG8_WAIT_L(0); PG8_BAR; PG8_MMA(1, 0, At, B0); PG8_MMA(1, 1, At, B1); PG8_BAR; PG8_SCHED;
            PG8_LDB(B0, 1, 0); PG8_LDB(B1, 1, 1); PG8_SCHED; PG8_LDA(At, 1, 0); PG8_STAGE(PG8_SA(0, 1), a2 + hstepA, voffA);
            PG8_WAIT_V(8); PG8_WAIT_L(0); PG8_BAR; PG8_MMA(0, 0, At, B0); PG8_MMA(0, 1, At, B1); PG8_BAR; PG8_SCHED;
            PG8_LDA(At, 1, 1); PG8_STAGE(PG8_SB(1, 0), b3, voffB); PG8_STAGE(PG8_SB(1, 1), b3 + hstepB, voffB); PG8_STAGE(PG8_SA(1, 0), a3, voffA);
            PG8_WAIT_V(8); PG8_WAIT_L(0); PG8_BAR; PG8_MMA(1, 0, At, B0); PG8_MMA(1, 1, At, B1); PG8_BAR; PG8_SCHED;
            } else {
            PG8_LDB(B0, 0, 0); PG8_SCHED; PG8_LDA(At, 0, 0); PG8_STAGE(PG8_SA(1, 1), a1 + hstepA, voffA);
            PG8_WAIT_L(8); PG8_BAR; PG8_WAIT_L(0); PG8_MMA(0, 0, At, B0); PG8_BAR; PG8_SCHED;
            PG8_LDB(B1, 0, 1); PG8_STAGE(PG8_SB(0, 0), b2, voffB);
            PG8_BAR; PG8_WAIT_L(0); PG8_MMA(0, 1, At, B1); PG8_BAR;
            PG8_LDA(At, 0, 1); PG8_STAGE(PG8_SA(0, 0), a2, voffA);
            PG8_BAR; PG8_WAIT_L(0); PG8_MMA(1, 0, At, B0); PG8_BAR; PG8_SCHED;
            PG8_STAGE(PG8_SB(0, 1), b2 + hstepB, voffB);
            PG8_WAIT_V(6); PG8_BAR; PG8_MMA(1, 1, At, B1); PG8_BAR;
            PG8_LDB(B0, 1, 0); PG8_SCHED; PG8_LDA(At, 1, 0); PG8_STAGE(PG8_SA(0, 1), a2 + hstepA, voffA);
            PG8_WAIT_L(8); PG8_BAR; PG8_WAIT_L(0); PG8_MMA(0, 0, At, B0); PG8_BAR; PG8_SCHED;
            PG8_LDB(B1, 1, 1); PG8_STAGE(PG8_SB(1, 0), b3, voffB);
            PG8_BAR; PG8_WAIT_L(0); PG8_MMA(0, 1, At, B1); PG8_BAR;
            PG8_LDA(At, 1, 1); PG8_STAGE(PG8_SA(1, 0), a3, voffA);
            PG8_BAR; PG8_WAIT_L(0); PG8_MMA(1, 0, At, B0); PG8_BAR; PG8_SCHED;
            PG8_STAGE(PG8_SB(1, 1), b3 + hstepB, voffB);
            PG8_WAIT_V(6); PG8_BAR; PG8_MMA(1, 1, At, B1); PG8_BAR;
            }
        }
        if constexpr (ALIGN_EPI) { if (wr == 0) PG8_BAR; }
        if constexpr (!Epi::AFTER_DRAIN) { int t2_; asm volatile("v_mbcnt_lo_u32_b32 %0, -1, 0\n\tv_mbcnt_hi_u32_b32 %0, -1, %0" : "=v"(t2_)); const int fr_ = t2_ & 15, fq_ = (t2_ >> 4) & 3; E(acc, cur, wr, wc, fr_, fq_); S.done(cur); }
        if (!has_next) break;
#pragma unroll
        for (int a = 0; a < 2; ++a)
#pragma unroll
            for (int b = 0; b < 2; ++b)
#pragma unroll
                for (int m = 0; m < 4; ++m)
#pragma unroll
                    for (int n = 0; n < 2; ++n) acc[a][b][m][n] = (f32x4){0.f, 0.f, 0.f, 0.f};
        cur = nxt; cA = nA; cB = nB; ++ui;
        if constexpr (ALIGN_EPI) { if (wr == 1) PG8_BAR; }
    }
    PG8_WAIT_V(0);
    if constexpr (!ALIGN_EPI) { if (wr == 0) PG8_BAR; }
    PG8_BAR;
    if constexpr (Epi::AFTER_DRAIN) { E.fused(acc, cur, wr, wc, fr, fq, lds, wid, lane); S.done(cur); }
#undef PG8_SA
#undef PG8_SB
#undef PG8_STAGE
#undef PG8_LDA
#undef PG8_LDB
#undef PG8_MMA
#undef PG8_WAIT_V
#undef PG8_WAIT_L
#undef PG8_BAR
#undef PG8_SCHED
}
}
using pg8::bf16_t; using pg8::bf16x8; using pg8::f32x4; using pg8::u32x4; using pg8::bf2f; using pg8::bflo; using pg8::bfhi; using pg8::cvt_pk_bf16; using pg8::sigmoidf_; using pg8::siluf_; using pg8::hsum4;
typedef float f32x16 __attribute__((ext_vector_type(16)));
typedef unsigned long long u64;
typedef u64 u64x2 __attribute__((ext_vector_type(2)));
typedef unsigned u32x2 __attribute__((ext_vector_type(2)));
#define LAS __attribute__((address_space(3)))
__device__ __forceinline__ int crow(int r, int hi) { return (r & 3) + 8 * (r >> 2) + 4 * hi; }
__device__ __forceinline__ float wave_sum(float v) {
#pragma unroll
    for (int o = 1; o < 64; o <<= 1) v += __shfl_xor(v, o);
    return v;
}

constexpr size_t MiB = 1u << 20;
constexpr size_t WS_LBS = 0;
constexpr size_t WS_BAR = WS_LBS + 16384;
constexpr size_t WS_ROPE = 64 * 1024;
constexpr size_t WS_DLAST = WS_ROPE + (size_t)LP * 16 * 2 * 4;
constexpr size_t WS_SSQ = WS_DLAST + (size_t)16 * NCH * 128 * 4;
constexpr size_t WS_SSQ2 = WS_SSQ + (size_t)MROWS * 16 * 4;
constexpr size_t WS_MISC_END = WS_SSQ2 + (size_t)MROWS * 24 * 4;
constexpr size_t WS_W = 8 * MiB;
static_assert(WS_MISC_END <= WS_W, "misc");
constexpr size_t WO_GU1 = 0, WO_D1 = WO_GU1 + (size_t)5632 * 1024, WO_IN1 = WO_D1 + (size_t)1024 * 2816, WO_G = WO_IN1 + (size_t)2816 * 1024,
                 WO_UQ = WO_G + (size_t)2048 * 1024, WO_K = WO_UQ + (size_t)768 * 384, WO_V = WO_K + (size_t)512 * 256, WO_P2 = WO_V + (size_t)512 * 256,
                 WO_O = WO_P2 + (size_t)2048 * 1024, WO_GU2 = WO_O + (size_t)1024 * 1024, WO_D2 = WO_GU2 + (size_t)5632 * 1024, WO_END = WO_D2 + (size_t)1024 * 2816;
constexpr size_t WS_H = WS_W + 50 * MiB;
static_assert(WO_END * 2 <= 50 * MiB, "weights");
constexpr size_t WS_HB = WS_H + (size_t)MROWS * DM * 4;
constexpr size_t WS_R2 = WS_HB + (size_t)MROWS * DM * 2;
constexpr size_t WS_R1 = WS_R2 + (size_t)MROWS * 2048 * 2;
constexpr size_t WS_S = WS_R1 + (size_t)MROWS * DM * 2;
constexpr size_t WS_END = WS_S + (size_t)16 * 128 * 128 * 128 * 2;
static_assert(WS_END <= 512 * MiB, "workspace map");
constexpr size_t DO_Q = 0, DO_KN = DO_Q + (size_t)MROWS * 768 * 2, DO_VT = DO_KN + (size_t)MROWS * 512 * 2, DO_KR = DO_VT + (size_t)MROWS * 512 * 2, DO_END = DO_KR + (size_t)MROWS * 32 * 2;
static_assert(DO_END <= (size_t)NBATCH * SEQ * DM * 4 && (size_t)MROWS * DM * 2 <= DO_VT, "d_out scratch map");

struct Args { const float* in[20]; float* out; unsigned char* ws; };
typedef const __attribute__((address_space(4))) Args* cargs_t;
__device__ __forceinline__ cargs_t launder_args(cargs_t p) { asm volatile("" : "+s"(p)); return p; }
#define ARGS_HERE const __attribute__((address_space(4))) Args& a = *launder_args(ap);

__device__ __forceinline__ void cvt_item(const float* src, int Ns, int scol0, int k0, bf16_t* dst, int Kd, int drow0, int kofs, const float* scale, LAS float* scr, int lane) {
#pragma unroll 8
    for (int i = 0; i < 32; ++i) { const int kk = 2 * i + (lane >> 5); float v = src[(size_t)(k0 + kk) * Ns + scol0 + (lane & 31)]; if (scale) v *= scale[k0 + kk]; scr[kk * 33 + (lane & 31)] = v; }
    asm volatile("s_waitcnt lgkmcnt(0)" ::: "memory");
    const int c = lane & 7;
#pragma unroll
    for (int j = 0; j < 4; ++j) { const int n = (lane >> 3) + 8 * j; const LAS float* s = scr + (8 * c) * 33 + n;
        u32x4 o; o.x = cvt_pk_bf16(s[0 * 33], s[1 * 33]); o.y = cvt_pk_bf16(s[2 * 33], s[3 * 33]); o.z = cvt_pk_bf16(s[4 * 33], s[5 * 33]); o.w = cvt_pk_bf16(s[6 * 33], s[7 * 33]);
        *(u32x4*)(dst + (size_t)(drow0 + n) * Kd + kofs + k0 + 8 * c) = o; }
    asm volatile("s_waitcnt lgkmcnt(0)" ::: "memory");
}
__device__ __forceinline__ void cvt_job(const float* src, int Ks, int Ns, const float* scale, bf16_t* dst, int Kd, int nblk, int mode, int soff, int doff, LAS float* scr, int gw, int NGW, int lane) {
    const int nitems = (Ks / 64) * nblk;
    for (int it = gw; it < nitems; it += NGW) { const int kb = it / nblk, nb = it % nblk; int scol0, drow0, kofs = 0;
        if (mode == 0) { scol0 = soff + 32 * nb; drow0 = doff + 32 * nb; }
        else if (mode == 1) { drow0 = 32 * nb; const int pn = drow0 >> 8, w = drow0 & 255; scol0 = (w < 128) ? 128 * pn + w : DFF + 128 * pn + (w - 128); }
        else if (mode == 2) { drow0 = 32 * nb; scol0 = 128 * (drow0 >> 6) + soff + (drow0 & 63); }
        else { const int c0 = 32 * nb; scol0 = c0; drow0 = 256 * (c0 >> 7) + (c0 & 127) + 128 * soff; kofs = 512 * soff; }
        cvt_item(src, Ns, scol0, 64 * kb, dst, Kd, drow0, kofs, scale, scr, lane); }
}
__device__ __forceinline__ void convert_layer(cargs_t ap, int l, unsigned char* lds, int wv_) { ARGS_HERE
    int tid_ = TIDX; asm volatile("" : "+v"(tid_)); const int tid = tid_, lane = tid & 63, wave = tid >> 6;
    LAS float* scr = (LAS float*)(LAS unsigned char*)lds + wave * 2176;
    const int gw = bid() * 8 + wave, NGW = gdim() * 8;
    bf16_t* W = (bf16_t*)(a.ws + WS_W);
    const float* ffn1_norm = a.in[2] + (size_t)l * DM; const float* ffn1_gu = a.in[3] + (size_t)l * DM * 5632; const float* ffn1_dn = a.in[4] + (size_t)l * DFF * DM;
    const float* mix_norm = a.in[5] + (size_t)l * DM; const float* w_in = a.in[6] + (size_t)l * DM * DIN; const float* q_norm = a.in[7] + (size_t)l * 384; const float* kv_norm = a.in[8] + (size_t)l * 256;
    const float* w_uq = a.in[9] + (size_t)l * 384 * 768; const float* w_ukv = a.in[10] + (size_t)l * 256 * 1024;
    const float* w_pa = a.in[13] + (size_t)l * 512 * DM; const float* w_pr = a.in[14] + (size_t)l * 512 * DM; const float* w_o = a.in[15] + (size_t)l * DM * DM;
    const float* ffn2_norm = a.in[16] + (size_t)l * DM; const float* ffn2_gu = a.in[17] + (size_t)l * DM * 5632; const float* ffn2_dn = a.in[18] + (size_t)l * DFF * DM;
    cvt_job(ffn1_gu, 1024, 5632, ffn1_norm, W + WO_GU1, 1024, 176, 1, 0, 0, scr, gw, NGW, lane);
    cvt_job(ffn1_dn, 2816, 1024, nullptr, W + WO_D1, 2816, 32, 0, 0, 0, scr, gw, NGW, lane);
    cvt_job(w_in, 1024, DIN, mix_norm, W + WO_IN1, 1024, 21, 0, 0, 0, scr, gw, NGW, lane);
    cvt_job(w_in, 1024, DIN, mix_norm, W + WO_IN1, 1024, 64, 0, 672, 768, scr, gw, NGW, lane);
    cvt_job(w_in, 1024, DIN, mix_norm, W + WO_G, 1024, 64, 0, 2720, 0, scr, gw, NGW, lane);
    cvt_job(w_uq, 384, 768, q_norm, W + WO_UQ, 384, 24, 0, 0, 0, scr, gw, NGW, lane);
    cvt_job(w_ukv, 256, 1024, kv_norm, W + WO_K, 256, 16, 2, 0, 0, scr, gw, NGW, lane);
    cvt_job(w_ukv, 256, 1024, kv_norm, W + WO_V, 256, 16, 2, 64, 0, scr, gw, NGW, lane);
    cvt_job(w_pa, 512, 1024, nullptr, W + WO_P2, 1024, 32, 3, 0, 0, scr, gw, NGW, lane);
    cvt_job(w_pr, 512, 1024, nullptr, W + WO_P2, 1024, 32, 3, 1, 0, scr, gw, NGW, lane);
    cvt_job(w_o, 1024, 1024, nullptr, W + WO_O, 1024, 32, 0, 0, 0, scr, gw, NGW, lane);
    cvt_job(ffn2_gu, 1024, 5632, ffn2_norm, W + WO_GU2, 1024, 176, 1, 0, 0, scr, gw, NGW, lane);
    cvt_job(ffn2_dn, 2816, 1024, nullptr, W + WO_D2, 2816, 32, 0, 0, 0, scr, gw, NGW, lane);
    const int gt = bid() * 512 + tid, NGT = gdim() * 512; unsigned zz_ = 0u; asm volatile("" : "+v"(zz_)); const u32x4 z = {zz_, zz_, zz_, zz_};
    for (int i = gt; i < 96 * 128; i += NGT) *(u32x4*)(W + WO_IN1 + (size_t)672 * 1024 + (size_t)i * 8) = z;
    for (int i = gt; i < 2048 * 64; i += NGT) { const int r = i >> 6, c = i & 63; const int half = ((r & 255) < 128) ? 1 : 0; *(u32x4*)(W + WO_P2 + (size_t)r * 1024 + half * 512 + c * 8) = z; }
}

__device__ __forceinline__ void init_phase(cargs_t ap, int wv_) { ARGS_HERE
    int tid_ = TIDX; asm volatile("" : "+v"(tid_)); const int tid = tid_, lane = tid & 63, wave = tid >> 6;
    const int gw = bid() * 8 + wave, NGW = gdim() * 8;
    bf16_t* hb = (bf16_t*)(a.ws + WS_HB); float* ssq = (float*)(a.ws + WS_SSQ);
    for (int r = gw; r < MROWS; r += NGW) { const int b = r / LP, p = r % LP;
        const float* src = (p < FRONT) ? nullptr : (p < 64 ? a.in[1] + (size_t)(p - FRONT) * DM : a.in[0] + ((size_t)b * SEQ + (p - 64)) * DM);
        float s = 0.f;
#pragma unroll
        for (int j = 0; j < 4; ++j) { f32x4 v = {0.f, 0.f, 0.f, 0.f}; if (src) v = *(const f32x4*)(src + 256 * j + 4 * lane);
            u32x2 w; w.x = cvt_pk_bf16(v[0], v[1]); w.y = cvt_pk_bf16(v[2], v[3]);
            *(u32x2*)(hb + (size_t)r * DM + 256 * j + 4 * lane) = w; s += hsum4(v * v); }
        s = wave_sum(s);
        if (lane < 16) ssq[(size_t)r * 16 + lane] = (lane == 0) ? s : 0.f; }
    const int gt = bid() * 512 + tid, NGT = gdim() * 512;
    float* lbs = (float*)(a.ws + WS_LBS); const float* raw = a.in[11];
    for (int c = gt; c < 512; c += NGT) { const float r0 = raw[c], r1 = raw[512 + c], r2 = raw[1024 + c], r3 = raw[1536 + c]; const float mx = fmaxf(fmaxf(r0, r1), fmaxf(r2, r3));
        const float e0 = __expf(r0 - mx), e1 = __expf(r1 - mx), e2 = __expf(r2 - mx), e3 = __expf(r3 - mx); const float inv = 1.f / (e0 + e1 + e2 + e3);
        lbs[c] = 0.f; lbs[512 + c] = e1 * inv; lbs[1024 + c] = (e1 + e2) * inv; lbs[1536 + c] = (e1 + e2 + e3) * inv; }
    float* rope = (float*)(a.ws + WS_ROPE);
    for (int i = gt; i < LP * 16; i += NGT) { const int p = i >> 4, j = i & 15; const int pos = p < FRONT ? 0 : p - FRONT;
        const float inv = powf(10000.0f, -(float)j / 16.0f); const float ang = (float)pos * inv;
        double t = (double)ang * 0.15915494309189535; t -= floor(t); const float tf = (float)t;
        rope[2 * i] = __builtin_amdgcn_cosf(tf); rope[2 * i + 1] = __builtin_amdgcn_sinf(tf); }
}
constexpr int AK_P = 104, AV_P = 68, AK_BUF = 64 * AK_P, AV_BUF = 64 * AV_P;
__device__ __forceinline__ void attn_tile(const bf16_t* Kt, const bf16_t* Vt_, const bf16x8 (&qf)[6], f32x16& o0, f32x16& o1, float& m_run, float& l_run, int kv0, int qw, int qrow, int r32, int hi, bool first) {
    if (kv0 > qw + 31) return;
    f32x16 p0, p1;
#pragma unroll
    for (int r = 0; r < 16; ++r) { p0[r] = 0.f; p1[r] = 0.f; }
    const bf16_t* kb = Kt + r32 * AK_P + 8 * hi;
#pragma unroll
    for (int j = 0; j < 6; ++j) { const bf16x8 k0 = *(const bf16x8*)(kb + 16 * j), k1 = *(const bf16x8*)(kb + 32 * AK_P + 16 * j);
        p0 = __builtin_amdgcn_mfma_f32_32x32x16_bf16(k0, qf[j], p0, 0, 0, 0); p1 = __builtin_amdgcn_mfma_f32_32x32x16_bf16(k1, qf[j], p1, 0, 0, 0); }
    if (kv0 + 63 > qw || first) {
#pragma unroll
        for (int r = 0; r < 16; ++r) { const int kv = kv0 + crow(r, hi); if (kv > qrow || kv < FRONT) p0[r] = -1e30f; if (kv + 32 > qrow || kv + 32 < FRONT) p1[r] = -1e30f; }
    }
    float mx = fmaxf(p0[0], p1[0]);
#pragma unroll
    for (int r = 1; r < 16; ++r) mx = fmaxf(mx, fmaxf(p0[r], p1[r]));
    { const auto rr_ = __builtin_amdgcn_permlane32_swap(__float_as_uint(mx), __float_as_uint(mx), false, false); mx = fmaxf(__uint_as_float(rr_[0]), __uint_as_float(rr_[1])); }
    const float m_new = fmaxf(m_run, mx); const float alpha = __builtin_amdgcn_exp2f(m_run - m_new); m_run = m_new;
    float rs = 0.f;
#pragma unroll
    for (int r = 0; r < 16; ++r) { p0[r] = __builtin_amdgcn_exp2f(p0[r] - m_new); p1[r] = __builtin_amdgcn_exp2f(p1[r] - m_new); rs += p0[r] + p1[r]; }
    l_run = l_run * alpha + rs;
    if (__any(alpha != 1.f)) {
#pragma unroll
        for (int r = 0; r < 16; ++r) { o0[r] *= alpha; o1[r] *= alpha; } }
    u32x4 pw[4];
#pragma unroll
    for (int s = 0; s < 2; ++s) {
        pw[s] = (u32x4){cvt_pk_bf16(p0[8 * s], p0[8 * s + 1]), cvt_pk_bf16(p0[8 * s + 2], p0[8 * s + 3]), cvt_pk_bf16(p0[8 * s + 4], p0[8 * s + 5]), cvt_pk_bf16(p0[8 * s + 6], p0[8 * s + 7])};
        pw[2 + s] = (u32x4){cvt_pk_bf16(p1[8 * s], p1[8 * s + 1]), cvt_pk_bf16(p1[8 * s + 2], p1[8 * s + 3]), cvt_pk_bf16(p1[8 * s + 4], p1[8 * s + 5]), cvt_pk_bf16(p1[8 * s + 6], p1[8 * s + 7])}; }
    const bf16_t* vb = Vt_ + r32 * AV_P + 4 * hi;
#pragma unroll
    for (int s = 0; s < 4; ++s) { const int kvo = 32 * (s >> 1) + 16 * (s & 1); const bf16x8 pa = __builtin_bit_cast(bf16x8, pw[s]);
        { const u64 a0 = *(const u64*)(vb + kvo), a1 = *(const u64*)(vb + kvo + 8); const bf16x8 vf = __builtin_bit_cast(bf16x8, (u64x2){a0, a1}); o0 = __builtin_amdgcn_mfma_f32_32x32x16_bf16(vf, pa, o0, 0, 0, 0); }
        { const u64 a0 = *(const u64*)(vb + 32 * AV_P + kvo), a1 = *(const u64*)(vb + 32 * AV_P + kvo + 8); const bf16x8 vf = __builtin_bit_cast(bf16x8, (u64x2){a0, a1}); o1 = __builtin_amdgcn_mfma_f32_32x32x16_bf16(vf, pa, o1, 0, 0, 0); } }
}
__device__ __forceinline__ void attn_unit(unsigned char* lds, const bf16_t* Q, const bf16_t* KN, const bf16_t* KR, const bf16_t* VT, bf16_t* AO, int b, int h, int q0, int NT, int nstore, int wv_) {
    int tid_ = TIDX; asm volatile("" : "+v"(tid_)); const int tid = tid_, lane = tid & 63, w = tid >> 6, r32 = lane & 31, hi = lane >> 5;
    bf16_t* Ks = (bf16_t*)lds; bf16_t* Vs = (bf16_t*)(lds + 2 * AK_BUF * 2);
    const int qw = q0 + 32 * w, qrow = qw + r32;
    const size_t rowb = (size_t)b * LP;
    bf16x8 qf[6];
    { const bf16_t* qp = Q + (rowb + qrow) * 768 + h * 96 + 8 * hi;
#pragma unroll
      for (int j = 0; j < 6; ++j) qf[j] = *(const bf16x8*)(qp + 16 * j); }
    f32x16 o0, o1;
#pragma unroll
    for (int r = 0; r < 16; ++r) { o0[r] = 0.f; o1[r] = 0.f; }
    float m_run = -1e30f, l_run = 0.f;
    const int lrow = tid >> 3, lch = tid & 7;
    const bf16_t* kn_p = KN + (rowb + lrow) * 512 + h * 64 + lch * 8;
    const bf16_t* vt_p = VT + (size_t)(h * 64 + lrow) * MROWS + rowb + lch * 8;
    const bf16_t* kr_p = KR + (rowb + (tid >> 2)) * 32 + (tid & 3) * 8;
    u32x4 rk0, rv0, rr0 = {0u, 0u, 0u, 0u}, rk1, rv1, rr1 = {0u, 0u, 0u, 0u};
#define A_GLOAD(t, S) do { rk##S = *(const u32x4*)(kn_p + (size_t)(t) * 64 * 512); rv##S = *(const u32x4*)(vt_p + (size_t)(t) * 64); if (tid < 256) rr##S = *(const u32x4*)(kr_p + (size_t)(t) * 64 * 32); } while (0)
#define A_LSTORE(buf, S) do { *(u32x4*)(Ks + (buf) * AK_BUF + lrow * AK_P + lch * 8) = rk##S; if (tid < 256) *(u32x4*)(Ks + (buf) * AK_BUF + (tid >> 2) * AK_P + 64 + (tid & 3) * 8) = rr##S; \
        u32x2 lo_ = {rv##S.x, rv##S.y}, hi_ = {rv##S.z, rv##S.w}; *(u32x2*)(Vs + (buf) * AV_BUF + lrow * AV_P + lch * 8) = lo_; *(u32x2*)(Vs + (buf) * AV_BUF + lrow * AV_P + lch * 8 + 4) = hi_; } while (0)
    A_GLOAD(0, 0); if (NT > 1) A_GLOAD(1, 1);
    A_LSTORE(0, 0); __syncthreads();
    for (int t = 0; t < NT; t += 2) {
        if (t + 2 < NT) A_GLOAD(t + 2, 0);
        attn_tile(Ks, Vs, qf, o0, o1, m_run, l_run, 64 * t, qw, qrow, r32, hi, t == 0);
        if (t + 1 < NT) A_LSTORE(1, 1);
        __syncthreads();
        if (t + 1 < NT) {
            if (t + 3 < NT) A_GLOAD(t + 3, 1);
            attn_tile(Ks + AK_BUF, Vs + AV_BUF, qf, o0, o1, m_run, l_run, 64 * (t + 1), qw, qrow, r32, hi, false);
            if (t + 2 < NT) A_LSTORE(0, 0);
            __syncthreads();
        }
    }
#undef A_GLOAD
#undef A_LSTORE
    const float lt = l_run + __shfl_xor(l_run, 32); const float inv = 1.f / lt;
    if (w < nstore) { bf16_t* op = AO + (rowb + qrow) * DM + h * 64 + 4 * hi;
#pragma unroll
        for (int g = 0; g < 4; ++g) { u32x2 a, c; a.x = cvt_pk_bf16(o0[4 * g] * inv, o0[4 * g + 1] * inv); a.y = cvt_pk_bf16(o0[4 * g + 2] * inv, o0[4 * g + 3] * inv);
            c.x = cvt_pk_bf16(o1[4 * g] * inv, o1[4 * g + 1] * inv); c.y = cvt_pk_bf16(o1[4 * g + 2] * inv, o1[4 * g + 3] * inv);
            *(u32x2*)(op + 8 * g) = a; *(u32x2*)(op + 32 + 8 * g) = c; } }
}
__device__ __forceinline__ void attn_phase(unsigned char* lds, cargs_t ap, int part, int wv_) { ARGS_HERE
    const bf16_t* Q = (const bf16_t*)((unsigned char*)a.out + DO_Q); const bf16_t* KN = (const bf16_t*)((unsigned char*)a.out + DO_KN);
    const bf16_t* VT = (const bf16_t*)((unsigned char*)a.out + DO_VT); const bf16_t* KR = (const bf16_t*)((unsigned char*)a.out + DO_KR);
    bf16_t* AO = (bf16_t*)(a.ws + WS_R1);
    for (int vv = bid(); vv < 256; vv += gdim()) { const int v = (vv & 7) * 32 + (vv >> 3);
        const int bh = v >> 3, s = v & 7, b = bh >> 3, h = bh & 7;
        if (part == 0 && s == 0) attn_unit(lds, Q, KN, KR, VT, AO, b, h, 0, 1, 2, wv_);
#pragma unroll 1
        for (int i = 0; i < 2; ++i) { const int blk = part == 0 ? (i == 0 ? s : 15 - s) : (i == 0 ? 16 + s : 31 - s);
            attn_unit(lds, Q, KN, KR, VT, AO, b, h, 64 + 256 * blk, 4 * blk + 5, 8, wv_); } }
}
__device__ __forceinline__ unsigned short f2bf_(float f) { return (unsigned short)(cvt_pk_bf16(f, 0.f) & 0xffffu); }
#define HG_GATES(hg4p, r0, hh, lb) \
    float bq[16], kk[16]; float total, hg_pre, hg_b1, hg_b2, hg_b3; { const float oml = 1.f - (lb); float run = 0.f; \
        _Pragma("unroll") for (int i = 0; i < 16; ++i) { const float z = bf2f((hg4p)[(size_t)((r0) + 16 * sq + i) * 2048 + 512 + (hh) * 128 + k]); const float sg = sigmoidf_(z); \
            const float f = (lb) + oml * sg; run += __logf(fmaxf(f, 1e-20f)); bq[i] = run; kk[i] = oml * (1.f - sg); } \
        part[sq * 128 + k] = run; __syncthreads(); \
        const float t0 = part[k], t1 = part[128 + k], t2 = part[256 + k], t3 = part[384 + k]; total = (t0 + t1) + (t2 + t3); \
        const float pre = (sq > 0 ? t0 : 0.f) + (sq > 1 ? t1 : 0.f) + (sq > 2 ? t2 : 0.f); \
        hg_pre = pre; hg_b1 = t0; hg_b2 = t0 + t1; hg_b3 = (t0 + t1) + t2; \
        _Pragma("unroll") for (int i = 0; i < 16; ++i) bq[i] += pre; }

__device__ __forceinline__ void hgrn_h1(unsigned char* lds, cargs_t ap, int l, int wv_) { ARGS_HERE
    int tid_ = TIDX; asm volatile("" : "+v"(tid_)); const int tid = tid_, lane = tid & 63, w = tid >> 6, k = tid & 127, sq = tid >> 7, fr = lane & 15, fq = lane >> 4;
    bf16_t* kdT = (bf16_t*)lds;
    bf16_t* vT = (bf16_t*)(lds + 18432);
    float* part = (float*)(lds + 36864);
    const bf16_t* hg4 = (const bf16_t*)(a.ws + WS_R2); const float* lbs = (const float*)(a.ws + WS_LBS) + l * 512;
    float* dlast = (float*)(a.ws + WS_DLAST); bf16_t* S = (bf16_t*)(a.ws + WS_S);
    for (int u = bid(); u < 16 * 128; u += gdim()) { const int bh = u >> 7, c = u & 127, b = bh >> 2, hh = bh & 3; const int r0 = b * LP + 64 * c;
        const float lb = lbs[hh * 128 + k];
        HG_GATES(hg4, r0, hh, lb)
        unsigned kw[8], vw[8];
#pragma unroll
        for (int i = 0; i < 8; ++i) { const float d0 = kk[2 * i] * __expf(total - bq[2 * i]), d1 = kk[2 * i + 1] * __expf(total - bq[2 * i + 1]); kw[i] = cvt_pk_bf16(d0, d1);
            const unsigned v0 = hg4[(size_t)(r0 + 16 * sq + 2 * i) * 2048 + 1024 + hh * 128 + k], v1 = hg4[(size_t)(r0 + 16 * sq + 2 * i + 1) * 2048 + 1024 + hh * 128 + k]; vw[i] = v0 | (v1 << 16); }
        *(u32x4*)(kdT + k * 72 + 16 * sq) = (u32x4){kw[0], kw[1], kw[2], kw[3]}; *(u32x4*)(kdT + k * 72 + 16 * sq + 8) = (u32x4){kw[4], kw[5], kw[6], kw[7]};
        *(u32x4*)(vT + k * 72 + 16 * sq) = (u32x4){vw[0], vw[1], vw[2], vw[3]}; *(u32x4*)(vT + k * 72 + 16 * sq + 8) = (u32x4){vw[4], vw[5], vw[6], vw[7]};
        if (sq == 0) dlast[((size_t)bh * NCH + c) * 128 + k] = __expf(total);
        __syncthreads();
        bf16x8 yv[2];
#pragma unroll
        for (int ks = 0; ks < 2; ++ks) yv[ks] = *(const bf16x8*)(vT + (16 * w + fr) * 72 + 32 * ks + 8 * fq);
        bf16_t* Sd = S + ((size_t)(bh * 128 + c) * 128 + 16 * w + fr) * 128 + 4 * fq;
#pragma unroll
        for (int kb = 0; kb < 8; ++kb) { f32x4 acc = {0.f, 0.f, 0.f, 0.f};
#pragma unroll
            for (int ks = 0; ks < 2; ++ks) { const bf16x8 xk = *(const bf16x8*)(kdT + (16 * kb + fr) * 72 + 32 * ks + 8 * fq); acc = __builtin_amdgcn_mfma_f32_16x16x32_bf16(xk, yv[ks], acc, 0, 0, 0); }
            u32x2 o; o.x = cvt_pk_bf16(acc[0], acc[1]); o.y = cvt_pk_bf16(acc[2], acc[3]); *(u32x2*)(Sd + 16 * kb) = o; }
        __syncthreads(); }
}
__device__ __forceinline__ void hgrn_h2(cargs_t ap, int wv_) { ARGS_HERE
    const float* dlast = (const float*)(a.ws + WS_DLAST); unsigned* S = (unsigned*)(a.ws + WS_S);
    for (int g = bid() * 512 + TIDX; g < 16 * 128 * 64; g += gdim() * 512) { const int bh = g >> 13, rem = g & 8191, v = rem >> 6, kp = rem & 63;
        unsigned* sp = S + (((size_t)bh * 128) * 128 + v) * 64 + kp; const float* dp = dlast + (size_t)bh * NCH * 128 + 2 * kp;
        float s0 = 0.f, s1 = 0.f;
        for (int c0 = 0; c0 < 128; c0 += 8) { unsigned loc[8]; float d0[8], d1[8];
#pragma unroll
            for (int j = 0; j < 8; ++j) { loc[j] = sp[(size_t)(c0 + j) * 128 * 64]; const float2 d = *(const float2*)(dp + (size_t)(c0 + j) * 128); d0[j] = d.x; d1[j] = d.y; }
#pragma unroll
            for (int j = 0; j < 8; ++j) { s0 = d0[j] * s0 + bflo(loc[j]); s1 = d1[j] * s1 + bfhi(loc[j]); sp[(size_t)(c0 + j) * 128 * 64] = cvt_pk_bf16(s0, s1); } } }
}
__device__ __forceinline__ void hgrn_h3(unsigned char* lds, cargs_t ap, int l, int wv_) { ARGS_HERE
    int tid_ = TIDX; asm volatile("" : "+v"(tid_)); const int tid = tid_, lane = tid & 63, w = tid >> 6, k = tid & 127, sq = tid >> 7, fr = lane & 15, fq = lane >> 4;
    float* bF = (float*)lds;
    bf16_t* qB = (bf16_t*)(lds + 33792);
    bf16_t* kB = (bf16_t*)(lds + 51200);
    bf16_t* qdB = (bf16_t*)(lds + 68608);
    bf16_t* vT = (bf16_t*)(lds + 86016);
    float* Ap = (float*)(lds + 104448);
    float* part = (float*)(lds + 137216);
    bf16_t* Ab = qB; bf16_t* KdB = (bf16_t*)lds; bf16_t* QdB = (bf16_t*)(lds + 104448);
    const bf16_t* hg4 = (const bf16_t*)(a.ws + WS_R2); const float* lbs = (const float*)(a.ws + WS_LBS) + l * 512; const float* normw = a.in[12] + (size_t)l * 128;
    const bf16_t* S = (const bf16_t*)(a.ws + WS_S); bf16_t* RO = (bf16_t*)(a.ws + WS_R1);
    for (int u = bid(); u < 16 * NCH; u += gdim()) { const int bh = u / NCH, c = u % NCH, b = bh >> 2, hh = bh & 3; const int r0 = b * LP + 64 * c;
        const float lb = lbs[hh * 128 + k];
        HG_GATES(hg4, r0, hh, lb)
        float qv[16];
        { unsigned vw[8];
#pragma unroll
          for (int i = 0; i < 16; ++i) { const int t = 16 * sq + i; bF[t * 132 + k] = bq[i]; kB[t * 136 + k] = f2bf_(kk[i]);
              qv[i] = siluf_(bf2f(hg4[(size_t)(r0 + t) * 2048 + hh * 128 + k])); qB[t * 136 + k] = f2bf_(qv[i]); qdB[t * 136 + k] = f2bf_(qv[i] * __expf(bq[i]) * HG_SCALE); }
#pragma unroll
          for (int i = 0; i < 8; ++i) { const unsigned v0 = hg4[(size_t)(r0 + 16 * sq + 2 * i) * 2048 + 1024 + hh * 128 + k], v1 = hg4[(size_t)(r0 + 16 * sq + 2 * i + 1) * 2048 + 1024 + hh * 128 + k]; vw[i] = v0 | (v1 << 16); }
          *(u32x4*)(vT + k * 72 + 16 * sq) = (u32x4){vw[0], vw[1], vw[2], vw[3]}; *(u32x4*)(vT + k * 72 + 16 * sq + 8) = (u32x4){vw[4], vw[5], vw[6], vw[7]}; }
        __syncthreads();
        { const int c4 = tid >> 7, blk = (tid >> 3) & 15, tb = blk >> 2, sb = blk & 3, kh = tid & 7;
          if (sb <= tb) { f32x4 ac[4];
#pragma unroll
              for (int i = 0; i < 4; ++i) ac[i] = (f32x4){0.f, 0.f, 0.f, 0.f};
              const int t0 = 16 * c4 + 4 * tb, s0 = 16 * c4 + 4 * sb;
#pragma unroll 1
              for (int k4 = 0; k4 < 4; ++k4) { const int kb = 16 * kh + 4 * k4; f32x4 bs[4], ks[4];
#pragma unroll
                  for (int j = 0; j < 4; ++j) { bs[j] = *(const f32x4*)(bF + (s0 + j) * 132 + kb); const u32x2 kw = *(const u32x2*)(kB + (s0 + j) * 136 + kb);
                      ks[j] = (f32x4){bflo(kw.x), bfhi(kw.x), bflo(kw.y), bfhi(kw.y)}; }
#pragma unroll
                  for (int i = 0; i < 4; ++i) { const f32x4 bt = *(const f32x4*)(bF + (t0 + i) * 132 + kb); const u32x2 qw = *(const u32x2*)(qB + (t0 + i) * 136 + kb);
                      const f32x4 qt = {bflo(qw.x), bfhi(qw.x), bflo(qw.y), bfhi(qw.y)};
#pragma unroll
                      for (int j = 0; j < 4; ++j)
#pragma unroll
                          for (int e = 0; e < 4; ++e) { const float d = fminf(bt[e] - bs[j][e], 0.f); ac[i][j] += qt[e] * ks[j][e] * __builtin_amdgcn_exp2f(d * 1.4426950408889634f); }
                      __builtin_amdgcn_sched_barrier(0); } }
#pragma unroll
              for (int i = 0; i < 4; ++i) *(f32x4*)(Ap + kh * 1024 + (t0 + i) * 16 + 4 * sb) = ac[i]; } }
        __syncthreads();
        { const int t = tid >> 3, s0 = (tid & 7) * 8; const int dsub = (s0 >> 4) - (t >> 4);
          if (dsub >= 0) { float v[8];
#pragma unroll
              for (int e = 0; e < 8; ++e) { const int s = s0 + e; float x = 0.f;
                  if (dsub == 0) {
#pragma unroll
                      for (int q8 = 0; q8 < 8; ++q8) x += Ap[q8 * 1024 + t * 16 + (s & 15)]; }
                  v[e] = (dsub == 0 && s <= t) ? x * HG_SCALE : 0.f; }
              *(u32x4*)(Ab + t * 72 + s0) = (u32x4){cvt_pk_bf16(v[0], v[1]), cvt_pk_bf16(v[2], v[3]), cvt_pk_bf16(v[4], v[5]), cvt_pk_bf16(v[6], v[7])}; } }
        __syncthreads();
        { if (sq >= 1) {
#pragma unroll
              for (int i = 0; i < 16; ++i) QdB[(16 * (sq - 1) + i) * 136 + k] = f2bf_(qv[i] * __expf(bq[i] - hg_pre)); }
#pragma unroll
          for (int ti = 1; ti < 4; ++ti) { if (ti > sq) { const float Bi = ti == 1 ? hg_b1 : (ti == 2 ? hg_b2 : hg_b3); const int roff = ti == 1 ? 0 : (ti == 2 ? 16 : 48);
#pragma unroll
                  for (int i = 0; i < 16; ++i) KdB[(roff + 16 * sq + i) * 136 + k] = f2bf_(kk[i] * __expf(Bi - bq[i])); } } }
        __syncthreads();
        if (w < 6) { const int ti = w == 0 ? 1 : (w < 3 ? 2 : 3), tj = w == 0 ? 0 : (w < 3 ? w - 1 : w - 3); const int roff = ti == 1 ? 0 : (ti == 2 ? 16 : 48);
            f32x4 acc = {0.f, 0.f, 0.f, 0.f};
#pragma unroll
            for (int ks = 0; ks < 4; ++ks) { const bf16x8 xk = *(const bf16x8*)(KdB + (roff + 16 * tj + fr) * 136 + 32 * ks + 8 * fq), yq = *(const bf16x8*)(QdB + (16 * (ti - 1) + fr) * 136 + 32 * ks + 8 * fq);
                acc = __builtin_amdgcn_mfma_f32_16x16x32_bf16(xk, yq, acc, 0, 0, 0); }
            u32x2 o; o.x = cvt_pk_bf16(acc[0] * HG_SCALE, acc[1] * HG_SCALE); o.y = cvt_pk_bf16(acc[2] * HG_SCALE, acc[3] * HG_SCALE);
            *(u32x2*)(Ab + (16 * ti + fr) * 72 + 16 * tj + 4 * fq) = o; }
        __syncthreads();
        { const int tb = w & 3, vh = w >> 2; f32x4 acc[4];
#pragma unroll
          for (int nb = 0; nb < 4; ++nb) acc[nb] = (f32x4){0.f, 0.f, 0.f, 0.f};
          if (c > 0) { const bf16_t* Sp = S + ((size_t)(bh * 128 + (c - 1)) * 128 + 64 * vh + fr) * 128 + 8 * fq;
#pragma unroll
              for (int ks = 0; ks < 4; ++ks) { const bf16x8 yq = *(const bf16x8*)(qdB + (16 * tb + fr) * 136 + 32 * ks + 8 * fq);
#pragma unroll
                  for (int nb = 0; nb < 4; ++nb) { const bf16x8 xs = *(const bf16x8*)(Sp + (size_t)nb * 16 * 128 + 32 * ks); acc[nb] = __builtin_amdgcn_mfma_f32_16x16x32_bf16(xs, yq, acc[nb], 0, 0, 0); } } }
#pragma unroll
          for (int ks = 0; ks < 2; ++ks) { const bf16x8 ya = *(const bf16x8*)(Ab + (16 * tb + fr) * 72 + 32 * ks + 8 * fq);
#pragma unroll
              for (int nb = 0; nb < 4; ++nb) { const bf16x8 xv = *(const bf16x8*)(vT + (64 * vh + 16 * nb + fr) * 72 + 32 * ks + 8 * fq); acc[nb] = __builtin_amdgcn_mfma_f32_16x16x32_bf16(xv, ya, acc[nb], 0, 0, 0); } }
          float ss = 0.f;
#pragma unroll
          for (int nb = 0; nb < 4; ++nb) ss += hsum4(acc[nb] * acc[nb]);
          ss += __shfl_xor(ss, 16); ss += __shfl_xor(ss, 32);
          if (fq == 0) part[vh * 64 + 16 * tb + fr] = ss;
          __syncthreads();
          const float tot = part[16 * tb + fr] + part[64 + 16 * tb + fr]; const float rn = rsqrtf(tot * (1.f / 128.f) + EPS);
          const int row = r0 + 16 * tb + fr;
#pragma unroll
          for (int nb = 0; nb < 4; ++nb) { const int vcol = 64 * vh + 16 * nb + 4 * fq; const u32x2 gw = *(const u32x2*)(hg4 + (size_t)row * 2048 + 1536 + hh * 128 + vcol); const f32x4 nw = *(const f32x4*)(normw + vcol);
              const float o0 = acc[nb][0] * rn * nw[0] * siluf_(bflo(gw.x)), o1 = acc[nb][1] * rn * nw[1] * siluf_(bfhi(gw.x)), o2 = acc[nb][2] * rn * nw[2] * siluf_(bflo(gw.y)), o3 = acc[nb][3] * rn * nw[3] * siluf_(bfhi(gw.y));
              u32x2 o; o.x = cvt_pk_bf16(o0, o1); o.y = cvt_pk_bf16(o2, o3); *(u32x2*)(RO + (size_t)row * DM + 512 + hh * 128 + vcol) = o; } }
        __syncthreads(); }
}
__device__ __forceinline__ void kr_rope(cargs_t ap, int wv_) { ARGS_HERE
    const bf16_t* zc = (const bf16_t*)(a.ws + WS_R1); bf16_t* kr = (bf16_t*)((unsigned char*)a.out + DO_KR); const float* rope = (const float*)(a.ws + WS_ROPE);
    for (int i = bid() * 512 + TIDX; i < MROWS * 16; i += gdim() * 512) { const int r = i >> 4, j = i & 15, p = r % LP;
        const float x1 = bf2f(zc[(size_t)r * 768 + 640 + j]), x2 = bf2f(zc[(size_t)r * 768 + 656 + j]); const float c = rope[((size_t)p * 16 + j) * 2], s = rope[((size_t)p * 16 + j) * 2 + 1];
        kr[(size_t)r * 32 + j] = f2bf_(x1 * c - x2 * s); kr[(size_t)r * 32 + 16 + j] = f2bf_(x2 * c + x1 * s); }
}
__device__ __forceinline__ void final_phase(cargs_t ap, int wv_) { ARGS_HERE
    const int lane = TIDX & 63, wave = TIDX >> 6; const bf16_t* hb = (const bf16_t*)(a.ws + WS_HB); const float* fw = a.in[19];
    for (int r = bid() * 8 + wave; r < NBATCH * SEQ; r += gdim() * 8) { const int b = r / SEQ, t = r % SEQ; const bf16_t* hp = hb + ((size_t)b * LP + 64 + t) * DM;
        f32x4 v[4]; float s = 0.f;
#pragma unroll
        for (int j = 0; j < 4; ++j) { const u32x2 w = *(const u32x2*)(hp + 256 * j + 4 * lane); v[j] = (f32x4){bflo(w.x), bfhi(w.x), bflo(w.y), bfhi(w.y)}; s += hsum4(v[j] * v[j]); }
        const float rs = rsqrtf(wave_sum(s) * (1.f / 1024.f) + EPS);
#pragma unroll
        for (int j = 0; j < 4; ++j) { const f32x4 wv = *(const f32x4*)(fw + 256 * j + 4 * lane); *(f32x4*)(a.out + (size_t)r * DM + 256 * j + 4 * lane) = v[j] * rs * wv; } }
}

#define XB_TMO      128
#define XB_XCNT(j)  (256  + 64 * (j))
#define XB_XSUB(j)  (1280 + 64 * (j))
#define XB_XGEN(j)  (2304 + 64 * (j))
#define XB_TOP      3328
#define XB_TOPGEN   3392
#define XCD_BAR_WORDS 3456
#define XB_SPIN_CAP (1u << 18)

__device__ __forceinline__ unsigned xb_ld(unsigned* p)              { return __hip_atomic_load(p, __ATOMIC_RELAXED, __HIP_MEMORY_SCOPE_AGENT); }
__device__ __forceinline__ unsigned xb_add(unsigned* p, unsigned v) { return __hip_atomic_fetch_add(p, v, __ATOMIC_RELAXED, __HIP_MEMORY_SCOPE_AGENT); }
__device__ __forceinline__ unsigned xb_xcc_id() { return (unsigned)__builtin_amdgcn_s_getreg((3 << 11) | 20) & 0xFu; }
#define XB_SPIN(cond, bar) do { unsigned _sp = 0; while (cond) { __builtin_amdgcn_s_sleep(1); \
    if ((++_sp & 255u) == 0u) { if (xb_ld(&(bar)[XB_TMO])) break; if (_sp > XB_SPIN_CAP) { atomicAdd(&(bar)[XB_TMO], 1u); break; } } } } while (0)

struct XcdBarrier {
    unsigned* bar; unsigned x;
    volatile LAS unsigned* st;
};

__device__ __forceinline__ XcdBarrier xcd_barrier_post(unsigned* bar, volatile LAS unsigned* st, int wv_) {
    XcdBarrier b; b.bar = bar; b.x = xb_xcc_id(); b.st = st;
    if (TIDX == 0) (void)xb_add(&bar[XB_XCNT(b.x)], 1u);
    return b;
}
__device__ __forceinline__ void xcd_barrier_complete(unsigned* bar, unsigned x, unsigned& nloc, unsigned& nx) {
    const unsigned G = gridDim.x * gridDim.y * gridDim.z;
    unsigned sum, cnt, mine, sp = 0u;
    for (;;) {
        sum = 0u; cnt = 0u; mine = 0u;
#pragma unroll
        for (unsigned j = 0; j < 16; ++j) { const unsigned c = xb_ld(&bar[XB_XCNT(j)]); sum += c; cnt += (c > 0u) ? 1u : 0u; mine = (j == x) ? c : mine; }
        if (sum == G) break;
        __builtin_amdgcn_s_sleep(1);
        if ((++sp & 255u) == 0u) { if (xb_ld(&bar[XB_TMO])) break; if (sp > XB_SPIN_CAP) { atomicAdd(&bar[XB_TMO], 1u); break; } }
    }
    nloc = mine > 0u ? mine : 1u; nx = cnt > 0u ? cnt : 1u;
}

__device__ __forceinline__ void xcd_barrier(const XcdBarrier& b, int wv_) {
    asm volatile("s_waitcnt vmcnt(0)" ::: "memory");
    __syncthreads();
    if (TIDX == 0) {
        unsigned* bar = b.bar;
        __builtin_amdgcn_s_waitcnt(0);
        unsigned nloc = b.st[0], nx = b.st[1];
        if (nloc == 0u) { xcd_barrier_complete(bar, b.x, nloc, nx); b.st[0] = nloc; b.st[1] = nx; }
        const unsigned old = xb_add(&bar[XB_XSUB(b.x)], 1u);
        const unsigned gen = old / nloc;
        if (old + 1u == (gen + 1u) * nloc) {
            __builtin_amdgcn_fence(__ATOMIC_RELEASE, "agent");
            asm volatile("s_waitcnt vmcnt(0)" ::: "memory");
            const unsigned og = xb_add(&bar[XB_TOP], 1u);
            const unsigned tg = og / nx;
            if (og + 1u == (tg + 1u) * nx) xb_add(&bar[XB_TOPGEN], 1u);
            else XB_SPIN(xb_ld(&bar[XB_TOPGEN]) == tg, bar);
            __builtin_amdgcn_fence(__ATOMIC_ACQUIRE, "agent");
            xb_add(&bar[XB_XGEN(b.x)], 1u);
            asm volatile("s_waitcnt vmcnt(0)" ::: "memory");
        } else {
            XB_SPIN(xb_ld(&bar[XB_XGEN(b.x)]) == gen, bar);
            __builtin_amdgcn_fence(__ATOMIC_ACQUIRE, "agent");
            asm volatile("s_waitcnt vmcnt(0)" ::: "memory");
        }
    }
    __syncthreads();
}

constexpr int LDS_BYTES = 147456;
#ifndef NPP_
#define NPP_ 2
#endif
#define GRID_SYNC_CG() do { asm volatile("s_waitcnt vmcnt(0) lgkmcnt(0)" ::: "memory"); grid.sync(); __builtin_amdgcn_fence(__ATOMIC_ACQUIRE, "agent"); asm volatile("s_waitcnt vmcnt(0)" ::: "memory"); } while (0)
constexpr int LDS_ST_OFF = LDS_BYTES - 64;
#define GRID_SYNC() do { ARGS_HERE XcdBarrier b_; b_.bar = (unsigned*)(a.ws + WS_BAR); b_.x = xb_xcc_id(); b_.st = (volatile LAS unsigned*)(ldsl + LDS_ST_OFF); xcd_barrier(b_, wv_); } while (0)
#if defined(SK_GEMM)
#define GEMM_RUN(EpiT, E, Aptr, lda_, Bptr, ldb_, M_, N_, K_) do { (void)(E); } while (0)
#else
#define GEMM_RUN(EpiT, E, Aptr, lda_, Bptr, ldb_, M_, N_, K_) do { pg8::Gemm g_{(Aptr), (Bptr), (lda_), (ldb_), (M_), (N_), (K_)}; pg8::StaticOrder S_; S_.init((M_), (N_), (int)gdim(), (int)bid()); \
        pg8::gemm_phase<EpiT, pg8::StaticOrder, true, true>(ldsl, g_, S_, (E), wv_); } while (0)
#endif
__global__ void __launch_bounds__(512, 2) mega_fwd(Args a_unused) {
    extern __shared__ __attribute__((aligned(16))) unsigned char lds[];
    cg::grid_group grid = cg::this_grid();
    LAS unsigned char* ldsl = (LAS unsigned char*)lds;
    const cargs_t ap = (cargs_t)__builtin_amdgcn_kernarg_segment_ptr();
    const int wv_ = __builtin_amdgcn_readfirstlane((int)threadIdx.x >> 6);
    if (TIDX < 16) ((volatile LAS unsigned*)(ldsl + LDS_ST_OFF))[TIDX] = 0u;
    __syncthreads();
    if (bid() == 0) { ARGS_HERE unsigned* bw = (unsigned*)(a.ws + WS_BAR); for (int i = TIDX; i < XCD_BAR_WORDS; i += 512) bw[i] = 0u; }
#define PH_BEGIN { ARGS_HERE unsigned char* ws = a.ws; unsigned char* dout = (unsigned char*)a.out; (void)ws; (void)dout;
#define PH_END } GRID_SYNC();
#define WSP(T, off) ((T*)(ws + (off)))
#define DOP(T, off) ((T*)(dout + (off)))
#if !defined(SK_INIT)
    init_phase(ap, wv_);
#endif
#pragma unroll 1
    for (int l = 0; l < DEPTH; ++l) {
#if !defined(SK_CVT)
        convert_layer(ap, lnd(l), lds, wv_);
#endif
        if (l == 0) { GRID_SYNC_CG(); ARGS_HERE (void)xcd_barrier_post((unsigned*)(a.ws + WS_BAR), (volatile LAS unsigned*)(ldsl + LDS_ST_OFF), wv_); }
        else GRID_SYNC();
        PH_BEGIN pg8::EpiFfnUp E{WSP(bf16_t, WS_R2), WSP(float, WS_SSQ)}; GEMM_RUN(pg8::EpiFfnUp, E, WSP(bf16_t, WS_HB), DM, WSP(bf16_t, WS_W) + WO_GU1, DM, MROWS, 5632, DM); PH_END
        PH_BEGIN pg8::EpiResid E{WSP(bf16_t, WS_HB), WSP(float, WS_SSQ), 0.5f, 0}; GEMM_RUN(pg8::EpiResid, E, WSP(bf16_t, WS_R2), DFF, WSP(bf16_t, WS_W) + WO_D1, DFF, MROWS, DM, DFF); PH_END
        PH_BEGIN pg8::EpiWin1 E{WSP(bf16_t, WS_R1), WSP(bf16_t, WS_R2), WSP(bf16_t, WS_H), WSP(float, WS_SSQ), WSP(float, WS_SSQ2)}; GEMM_RUN(pg8::EpiWin1, E, WSP(bf16_t, WS_HB), DM, WSP(bf16_t, WS_W) + WO_IN1, DM, MROWS, 4864, DM); PH_END
#if !defined(SK_KR)
        kr_rope(ap, wv_);
#endif
        { ARGS_HERE unsigned char* ws = a.ws; unsigned char* dout = (unsigned char*)a.out; pg8::EpiQ E{DOP(bf16_t, DO_Q), WSP(float, WS_SSQ2), WSP(float, WS_ROPE)}; GEMM_RUN(pg8::EpiQ, E, WSP(bf16_t, WS_R1), 768, WSP(bf16_t, WS_W) + WO_UQ, 384, MROWS, 768, 384); }
        { ARGS_HERE unsigned char* ws = a.ws; unsigned char* dout = (unsigned char*)a.out; pg8::EpiKn E{DOP(bf16_t, DO_KN), WSP(float, WS_SSQ2)}; GEMM_RUN(pg8::EpiKn, E, WSP(bf16_t, WS_R1) + 384, 768, WSP(bf16_t, WS_W) + WO_K, 256, MROWS, 512, 256); }
        { ARGS_HERE unsigned char* ws = a.ws; unsigned char* dout = (unsigned char*)a.out; pg8::EpiVt E{DOP(bf16_t, DO_VT), WSP(float, WS_SSQ2)}; GEMM_RUN(pg8::EpiVt, E, WSP(bf16_t, WS_W) + WO_V, 256, WSP(bf16_t, WS_R1) + 384, 768, 512, MROWS, 256); }
#if !defined(SK_H1)
        hgrn_h1(lds, ap, lnd(l), wv_);
#endif
        GRID_SYNC();
#pragma unroll 1
        for (int pp = 0, npp = lnd(NPP_); pp < npp; ++pp) { const int part = (pp == npp - 1) ? 1 : 0;
            if (pp == 0) hgrn_h2(ap, wv_);
            attn_phase(lds, ap, part, wv_);
            if (pp == npp - 1) hgrn_h3(lds, ap, lnd(l), wv_);
            GRID_SYNC(); }
        PH_BEGIN pg8::EpiMerge E{DOP(bf16_t, DO_Q), WSP(bf16_t, WS_H)}; GEMM_RUN(pg8::EpiMerge, E, WSP(bf16_t, WS_R1), DM, WSP(bf16_t, WS_W) + WO_P2, DM, MROWS, 2048, DM); PH_END
        PH_BEGIN pg8::EpiResid E{WSP(bf16_t, WS_HB), WSP(float, WS_SSQ), 1.0f, 1}; GEMM_RUN(pg8::EpiResid, E, DOP(bf16_t, DO_Q), DM, WSP(bf16_t, WS_W) + WO_O, DM, MROWS, DM, DM); PH_END
        PH_BEGIN pg8::EpiFfnUp E{WSP(bf16_t, WS_R2), WSP(float, WS_SSQ)}; GEMM_RUN(pg8::EpiFfnUp, E, WSP(bf16_t, WS_HB), DM, WSP(bf16_t, WS_W) + WO_GU2, DM, MROWS, 5632, DM); PH_END
        PH_BEGIN pg8::EpiResid E{WSP(bf16_t, WS_HB), WSP(float, WS_SSQ), 0.5f, 0}; GEMM_RUN(pg8::EpiResid, E, WSP(bf16_t, WS_R2), DFF, WSP(bf16_t, WS_W) + WO_D2, DFF, MROWS, DM, DFF); PH_END
    }
#if !defined(SK_FIN)
    final_phase(ap, wv_);
#endif
}

extern "C" void kernel_launch(void* const* d_in, const int* in_sizes, int n_in, void* d_out, int out_size, void* d_ws, size_t ws_size, hipStream_t stream) {
    static int grid_blocks = 0;
    if (grid_blocks == 0) {
        if (n_in != 20 || ws_size < WS_END || out_size != NBATCH * SEQ * DM) { fprintf(stderr, "kernel_launch: unexpected shapes (n_in %d, ws %zu, out %d)\n", n_in, ws_size, out_size); grid_blocks = -1; return; }
        int dev = 0, cus = 0, per_cu = 0;
        (void)hipGetDevice(&dev); (void)hipDeviceGetAttribute(&cus, hipDeviceAttributeMultiprocessorCount, dev);
        if (hipFuncSetAttribute((const void*)mega_fwd, hipFuncAttributeMaxDynamicSharedMemorySize, LDS_BYTES) != hipSuccess) { fprintf(stderr, "kernel_launch: hipFuncSetAttribute failed\n"); grid_blocks = -1; return; }
        if (hipOccupancyMaxActiveBlocksPerMultiprocessor(&per_cu, (const void*)mega_fwd, 512, LDS_BYTES) != hipSuccess || per_cu < 1) { fprintf(stderr, "kernel_launch: occupancy query gave %d\n", per_cu); per_cu = 1; }
        (void)hipGetLastError();
        grid_blocks = cus * per_cu;
    }
    if (grid_blocks < 0) return;
    Args a{};
    for (int i = 0; i < 20; ++i) a.in[i] = (const float*)d_in[i];
    a.out = (float*)d_out; a.ws = (unsigned char*)d_ws;
    void* args[] = {&a};
    hipError_t e = hipLaunchCooperativeKernel((const void*)mega_fwd, dim3(grid_blocks), dim3(512), args, LDS_BYTES, stream);
    if (e != hipSuccess) fprintf(stderr, "cooperative launch failed: %s (grid %d)\n", hipGetErrorString(e), grid_blocks);
}
```

```cpp
#include <hip/hip_runtime.h>
#include <hip/hip_cooperative_groups.h>
#include <cstdio>
#include <cstdint>
namespace cg = cooperative_groups;
__device__ __forceinline__ int bid() { int b = (int)__builtin_amdgcn_workgroup_id_x(); asm volatile("" : "+s"(b)); return b; }
__device__ __forceinline__ int lane_id_() { int l; asm volatile("v_mbcnt_lo_u32_b32 %0, -1, 0\n\tv_mbcnt_hi_u32_b32 %0, -1, %0" : "=v"(l)); return l; }
#define TIDX ((wv_ << 6) | lane_id_())
__device__ __forceinline__ int lnd(int l) { asm volatile("" : "+s"(l)); return l; }
__device__ __forceinline__ int gdim() { int g = (int)(__builtin_amdgcn_grid_size_x() / 512u); asm volatile("" : "+s"(g)); return g; }

constexpr int DM = 1024, NBATCH = 4, SEQ = 8192, DEPTH = 4, NMETA = 16;
constexpr int FRONT = 48, LP = 8256  , MROWS = NBATCH * LP  ;
constexpr int DFF = 2816, DIN = 4768, NCH = LP / 64  ;
constexpr float EPS = 1e-6f;
constexpr float C2Q = 0.10206207261596575f * 1.4426950408889634f;
constexpr float HG_SCALE = 0.08838834764831845f;

namespace pg8 {
#define PG8_LAS __attribute__((address_space(3)))
typedef unsigned short bf16_t;
typedef short bf16x8 __attribute__((ext_vector_type(8)));
typedef float f32x4 __attribute__((ext_vector_type(4)));
typedef unsigned u32x4 __attribute__((ext_vector_type(4)));
constexpr int BM = 256, BK = 64, HALF = 128, HTB = HALF * BK * 2  , STAGE_BYTES = 8 * HTB, NXCD = 8, WGM = 8;
__host__ __device__ __forceinline__ int lds_byte(int r, int c) { const int st = (r >> 4) * 2 + (c >> 5), rr = r & 15, cc = c & 31, ob = rr * 64 + cc * 2; return st * 1024 + (ob ^ (((ob >> 9) & 1) << 5)); }
__host__ __device__ __forceinline__ void stage_rc(int b, int& R, int& C) { const int st = b / 1024, sb = b % 1024, swz = sb ^ (((sb >> 9) & 1) << 5); R = (st >> 1) * 16 + swz / 64; C = (st & 1) * 32 + (swz % 64) / 2; }
__host__ __device__ __forceinline__ int perm32(int rho) { const int n = rho >> 4, i = rho & 15; return 8 * (i >> 2) + 4 * n + (i & 3); }
struct Unit { int pm, pn; };
struct Gemm { const bf16_t* A; const bf16_t* Bt; int lda, ldb; int M, N, K; };
struct StaticOrder {
    int nM, nN, nwg, G, c;
    __host__ __device__ void init(int M, int N, int G_, int c_) { nM = M / BM; nN = N / BM; nwg = nM * nN; G = G_; c = c_; }
    __host__ __device__ bool next(int i, Unit& u) const {
        const long L = (long)i * G + c; if (L >= nwg) return false;
        int wgid = (int)L; { const int q = nwg / NXCD, r = nwg % NXCD, xcd = wgid % NXCD, off = wgid / NXCD; wgid = (xcd < r ? xcd * (q + 1) : r * (q + 1) + (xcd - r) * q) + off; }
        const int nig = WGM * nN, gid = wgid / nig, fm = gid * WGM, gsz = (nM - fm) < WGM ? (nM - fm) : WGM;
        u.pm = fm + ((wgid % nig) % gsz); u.pn = (wgid % nig) / gsz; return true;
    }
    __device__ __forceinline__ void a_ready(const Unit&) const {}
    __device__ __forceinline__ void done(const Unit&) const {}
};
typedef float f32x2_t __attribute__((ext_vector_type(2))); typedef __bf16 bf16x2_t __attribute__((ext_vector_type(2)));
__device__ __forceinline__ unsigned cvt_pk_bf16(float lo, float hi) { f32x2_t v = {lo, hi}; bf16x2_t b = __builtin_convertvector(v, bf16x2_t); return __builtin_bit_cast(unsigned, b); }
__device__ __forceinline__ float bf2f(unsigned short b) { return __uint_as_float((unsigned)b << 16); }
__device__ __forceinline__ float bflo(unsigned w) { return __uint_as_float(w << 16); }
__device__ __forceinline__ float bfhi(unsigned w) { return __uint_as_float(w & 0xffff0000u); }
__device__ __forceinline__ float sigmoidf_(float x) { return __builtin_amdgcn_rcpf(1.f + __builtin_amdgcn_exp2f(-1.4426950408889634f * x)); }
__device__ __forceinline__ float siluf_(float x) { return x * sigmoidf_(x); }
__device__ __forceinline__ float hsum4(f32x4 a) { return (a[0] + a[1]) + (a[2] + a[3]); }
__device__ __forceinline__ float rstd16(const float* ssq, int row) {
    const f32x4* p = (const f32x4*)(ssq + (size_t)row * 16); const f32x4 a = p[0], b = p[1], c = p[2], d = p[3];
    const float s = (hsum4(a) + hsum4(b)) + (hsum4(c) + hsum4(d)); return rsqrtf(s * (1.f / 1024.f) + EPS);
}
__device__ __forceinline__ u32x4 pack8(f32x4 v0, f32x4 v1) { u32x4 w; w.x = cvt_pk_bf16(v0[0], v0[1]); w.y = cvt_pk_bf16(v0[2], v0[3]); w.z = cvt_pk_bf16(v1[0], v1[1]); w.w = cvt_pk_bf16(v1[2], v1[3]); return w; }
#define EPI_SIG (const f32x4 (&acc)[2][2][4][2], const Unit& u, int wr, int wc, int fr, int fq) const
#define EPI_ROWS _Pragma("unroll") for (int ai = 0; ai < 2; ++ai) _Pragma("unroll") for (int m = 0; m < 4; ++m)
#define EPI_ROW (u.pm * BM + ai * HALF + wr * 64 + m * 16 + fr)

struct EpiFfnUp { static constexpr bool PERM = true, AFTER_DRAIN = false; bf16_t* H; const float* ssq;
    __device__ __forceinline__ void operator() EPI_SIG {
        const int colo = u.pn * 128 + wc * 32 + 8 * fq;
        EPI_ROWS { const int row = EPI_ROW; const float rs = rstd16(ssq, row);
            f32x4 o[2];
#pragma unroll
            for (int n = 0; n < 2; ++n) { const f32x4 g = acc[ai][0][m][n] * rs, up = acc[ai][1][m][n] * rs;
#pragma unroll
                for (int e = 0; e < 4; ++e) o[n][e] = siluf_(g[e]) * up[e]; }
            *(u32x4*)(H + (size_t)row * DFF + colo) = pack8(o[0], o[1]); asm volatile("" ::: "memory"); }
    }
};
struct EpiResid { static constexpr bool PERM = true, AFTER_DRAIN = false; bf16_t* hb; float* ssq; float alpha; int maskpad;
    __device__ __forceinline__ void operator() EPI_SIG {
        EPI_ROWS { const int row = EPI_ROW; const bool pad = maskpad && ((row % LP) < FRONT); float s = 0.f;
#pragma unroll
            for (int bj = 0; bj < 2; ++bj) { const int col0 = u.pn * BM + bj * HALF + wc * 32 + 8 * fq; bf16_t* hp = hb + (size_t)row * DM + col0;
                const u32x4 hw = *(const u32x4*)hp;
                f32x4 a0 = {bflo(hw.x), bfhi(hw.x), bflo(hw.y), bfhi(hw.y)}, a1 = {bflo(hw.z), bfhi(hw.z), bflo(hw.w), bfhi(hw.w)};
                a0 = a0 + acc[ai][bj][m][0] * alpha; a1 = a1 + acc[ai][bj][m][1] * alpha;
                if (pad) { a0 = (f32x4){0.f, 0.f, 0.f, 0.f}; a1 = a0; }
                *(u32x4*)hp = pack8(a0, a1);
                s += hsum4(a0 * a0) + hsum4(a1 * a1); }
            s += __shfl_xor(s, 16); s += __shfl_xor(s, 32);
            if (fq == 0) ssq[(size_t)row * 16 + u.pn * 4 + wc] = s; asm volatile("" ::: "memory"); }
    }
};
struct EpiWin1 { static constexpr bool PERM = true, AFTER_DRAIN = false; bf16_t* zc; bf16_t* hg4; bf16_t* G; const float* ssq; float* ssq2;
    __device__ __forceinline__ void operator() EPI_SIG {
        EPI_ROWS { const int row = EPI_ROW; const float rs = rstd16(ssq, row);
#pragma unroll
            for (int bj = 0; bj < 2; ++bj) { const int col0 = u.pn * BM + bj * HALF + wc * 32 + 8 * fq;
                const f32x4 v0 = acc[ai][bj][m][0] * rs, v1 = acc[ai][bj][m][1] * rs; const u32x4 w = pack8(v0, v1);
                if (u.pn < 3) { *(u32x4*)(zc + (size_t)row * 768 + col0) = w;
                    float s = hsum4(v0 * v0) + hsum4(v1 * v1); s += __shfl_xor(s, 16); s += __shfl_xor(s, 32);
                    if (fq == 0) ssq2[(size_t)row * 24 + (u.pn * 2 + bj) * 4 + wc] = s; }
                else if (u.pn < 11) *(u32x4*)(hg4 + (size_t)row * 2048 + (col0 - 768)) = w;
                else { f32x4 g0, g1;
#pragma unroll
                    for (int e = 0; e < 4; ++e) { g0[e] = sigmoidf_(v0[e]); g1[e] = sigmoidf_(v1[e]); }
                    *(u32x4*)(G + (size_t)row * 2048 + (col0 - 2816)) = pack8(g0, g1); } } asm volatile("" ::: "memory"); }
    }
};
struct EpiQ { static constexpr bool PERM = true, AFTER_DRAIN = false; bf16_t* q; const float* ssq2; const float* rope;
    __device__ __forceinline__ void operator() EPI_SIG {
        EPI_ROWS { const int row = EPI_ROW; const int p = row % LP;
            const f32x4* sp = (const f32x4*)(ssq2 + (size_t)row * 24); const float ss = hsum4(sp[0]) + hsum4(sp[1]) + hsum4(sp[2]);
            const float rs = rsqrtf(ss * (1.f / 384.f) + EPS);
#pragma unroll
            for (int bj = 0; bj < 2; ++bj) { const int g = u.pn * 8 + bj * 4 + wc; const int col0 = u.pn * BM + bj * HALF + wc * 32 + 8 * fq;
                f32x4 v0 = acc[ai][bj][m][0] * rs, v1 = acc[ai][bj][m][1] * rs;
                if (g % 3 == 2) { const f32x4* rp = (const f32x4*)(rope + ((size_t)p * 16 + 8 * (fq & 1)) * 2); const bool lo = fq < 2;
#pragma unroll
                    for (int e2 = 0; e2 < 4; ++e2) { const f32x4 cs = rp[e2];
#pragma unroll
                        for (int k = 0; k < 2; ++k) { const int e = 2 * e2 + k; const float mine = e < 4 ? v0[e & 3] : v1[e & 3]; const float oth = __shfl_xor(mine, 32);
                            const float c = cs[2 * k], sn = cs[2 * k + 1]; const float r = lo ? (mine * c - oth * sn) : (mine * c + oth * sn);
                            if (e < 4) v0[e & 3] = r; else v1[e & 3] = r; } } }
                v0 = v0 * C2Q; v1 = v1 * C2Q; *(u32x4*)(q + (size_t)row * 768 + col0) = pack8(v0, v1); } asm volatile("" ::: "memory"); }
    }
};
struct EpiKn { static constexpr bool PERM = true, AFTER_DRAIN = false; bf16_t* kn; const float* ssq2;
    __device__ __forceinline__ void operator() EPI_SIG {
        EPI_ROWS { const int row = EPI_ROW; const f32x4* sp = (const f32x4*)(ssq2 + (size_t)row * 24 + 12); const float rs = rsqrtf((hsum4(sp[0]) + hsum4(sp[1])) * (1.f / 256.f) + EPS);
#pragma unroll
            for (int bj = 0; bj < 2; ++bj) { const int col0 = u.pn * BM + bj * HALF + wc * 32 + 8 * fq;
                *(u32x4*)(kn + (size_t)row * 512 + col0) = pack8(acc[ai][bj][m][0] * rs, acc[ai][bj][m][1] * rs); } asm volatile("" ::: "memory"); }
    }
};
struct EpiVt { static constexpr bool PERM = true, AFTER_DRAIN = false; bf16_t* vt; const float* ssq2;
    __device__ __forceinline__ void operator() EPI_SIG {
#pragma unroll
        for (int bj = 0; bj < 2; ++bj) { const int col0 = u.pn * BM + bj * HALF + wc * 32 + 8 * fq; f32x4 rs0, rs1;
#pragma unroll
            for (int e = 0; e < 8; ++e) { const f32x4* sp = (const f32x4*)(ssq2 + (size_t)(col0 + e) * 24 + 12); const float r = rsqrtf((hsum4(sp[0]) + hsum4(sp[1])) * (1.f / 256.f) + EPS);
                if (e < 4) rs0[e & 3] = r; else rs1[e & 3] = r; if (e & 1) asm volatile("" ::: "memory"); }
            EPI_ROWS { const int row = EPI_ROW; *(u32x4*)(vt + (size_t)row * MROWS + col0) = pack8(acc[ai][bj][m][0] * rs0, acc[ai][bj][m][1] * rs1); asm volatile("" ::: "memory"); } }
    }
};
struct EpiGate { static constexpr bool PERM = true, AFTER_DRAIN = false; bf16_t* G; const float* ssq;
    __device__ __forceinline__ void operator() EPI_SIG {
        EPI_ROWS { const int row = EPI_ROW; const float rs = rstd16(ssq, row);
#pragma unroll
            for (int bj = 0; bj < 2; ++bj) { const int col0 = u.pn * BM + bj * HALF + wc * 32 + 8 * fq; f32x4 o[2];
#pragma unroll
                for (int n = 0; n < 2; ++n) { const f32x4 v = acc[ai][bj][m][n] * rs;
#pragma unroll
                    for (int e = 0; e < 4; ++e) o[n][e] = sigmoidf_(v[e]); }
                *(u32x4*)(G + (size_t)row * 2048 + col0) = pack8(o[0], o[1]); } asm volatile("" ::: "memory"); }
    }
};
struct EpiMerge { static constexpr bool PERM = true, AFTER_DRAIN = false; bf16_t* mg; const bf16_t* G;
    __device__ __forceinline__ void operator() EPI_SIG {
        const int colo = u.pn * 128 + wc * 32 + 8 * fq;
        EPI_ROWS { const int row = EPI_ROW; const u32x4 ga = *(const u32x4*)(G + (size_t)row * 2048 + colo), gb = *(const u32x4*)(G + (size_t)row * 2048 + 1024 + colo);
            f32x4 o0, o1; const f32x4 a0 = acc[ai][0][m][0], a1 = acc[ai][0][m][1], b0 = acc[ai][1][m][0], b1 = acc[ai][1][m][1];
            o0[0] = bflo(ga.x) * a0[0] + bflo(gb.x) * b0[0]; o0[1] = bfhi(ga.x) * a0[1] + bfhi(gb.x) * b0[1];
            o0[2] = bflo(ga.y) * a0[2] + bflo(gb.y) * b0[2]; o0[3] = bfhi(ga.y) * a0[3] + bfhi(gb.y) * b0[3];
            o1[0] = bflo(ga.z) * a1[0] + bflo(gb.z) * b1[0]; o1[1] = bfhi(ga.z) * a1[1] + bfhi(gb.z) * b1[1];
            o1[2] = bflo(ga.w) * a1[2] + bflo(gb.w) * b1[2]; o1[3] = bfhi(ga.w) * a1[3] + bfhi(gb.w) * b1[3];
            *(u32x4*)(mg + (size_t)row * DM + colo) = pack8(o0, o1); asm volatile("" ::: "memory"); }
    }
};
template <class Epi, class Sched, bool ALIGN_EPI = false, bool SP2 = false>
__device__ __forceinline__ void gemm_phase(PG8_LAS unsigned char* lds, const Gemm g, const Sched& S, const Epi& E, int wv_) {
    int tid_ = TIDX; asm volatile("" : "+v"(tid_)); const int tid = tid_, wid = wv_, lane = tid & 63, wr = wid >> 2, wc = wid & 3, fr = lane & 15, fq = lane >> 4;
    const int K = g.K, nt = K / BK;
    unsigned voffA[2], voffB[2];
#pragma unroll
    for (int i = 0; i < 2; ++i) { int R, C; stage_rc(tid * 16 + i * 8192, R, C); const int Rb = Epi::PERM ? ((R & ~31) + perm32(R & 31)) : R;
        voffA[i] = (unsigned)(R * g.lda + C) * 2u; voffB[i] = (unsigned)(Rb * g.ldb + C) * 2u; }
    const size_t kstep = (size_t)(BK * 2);
    const size_t hstepA = (size_t)HALF * g.lda * 2, hstepB = (size_t)HALF * g.ldb * 2;
    const size_t tstepA = 2 * hstepA, tstepB = 2 * hstepB;
    const unsigned ldsw = (unsigned)wid * 1024u;
    const int aoff = lds_byte(wr * 64 + fr, fq * 8), boff = lds_byte(wc * 32 + fr, fq * 8);
#define PG8_SA(b, h) (((b) * 2 + (h)) * HTB)
#define PG8_SB(b, h) ((4 + (b) * 2 + (h)) * HTB)
#define PG8_STAGE(bufoff, gbase, voff) do { _Pragma("unroll") for (int _i = 0; _i < 2; ++_i) \
        __builtin_amdgcn_global_load_lds((const unsigned*)((const char*)(gbase) + (voff)[_i]), (PG8_LAS unsigned*)(lds + (bufoff) + ldsw + _i * 8192), 16, 0, 0); } while (0)
#define PG8_LDA(dst, b, h) do { _Pragma("unroll") for (int m = 0; m < 4; ++m) _Pragma("unroll") for (int k = 0; k < 2; ++k) dst[m][k] = *(const PG8_LAS bf16x8*)(lds + PG8_SA(b, h) + aoff + m * 2048 + k * 1024); } while (0)
#define PG8_LDB(dst, b, h) do { _Pragma("unroll") for (int n = 0; n < 2; ++n) _Pragma("unroll") for (int k = 0; k < 2; ++k) dst[n][k] = *(const PG8_LAS bf16x8*)(lds + PG8_SB(b, h) + boff + n * 2048 + k * 1024); } while (0)
#define PG8_MMA(ai, bj, At, Bt) do { __builtin_amdgcn_s_setprio(1); _Pragma("unroll") for (int m = 0; m < 4; ++m) _Pragma("unroll") for (int n = 0; n < 2; ++n) _Pragma("unroll") for (int k = 0; k < 2; ++k) \
        acc[ai][bj][m][n] = __builtin_amdgcn_mfma_f32_16x16x32_bf16(Bt[n][k], At[m][k], acc[ai][bj][m][n], 0, 0, 0); __builtin_amdgcn_s_setprio(0); } while (0)
#define PG8_WAIT_V(n) asm volatile("s_waitcnt vmcnt(" #n ")" ::: "memory")
#define PG8_WAIT_L(n) asm volatile("s_waitcnt lgkmcnt(" #n ")" ::: "memory")
#define PG8_BAR __builtin_amdgcn_s_barrier()
#define PG8_SCHED __builtin_amdgcn_sched_barrier(0)
    Unit cur, nxt; int ui = 0;
    if (!S.next(0, cur)) return;
    f32x4 acc[2][2][4][2];
#pragma unroll
    for (int a = 0; a < 2; ++a)
#pragma unroll
        for (int b = 0; b < 2; ++b)
#pragma unroll
            for (int m = 0; m < 4; ++m)
#pragma unroll
                for (int n = 0; n < 2; ++n) acc[a][b][m][n] = (f32x4){0.f, 0.f, 0.f, 0.f};
    bf16x8 At[4][2], B0[2][2], B1[2][2];
    const char* cA = (const char*)g.A + (size_t)cur.pm * tstepA; const char* cB = (const char*)g.Bt + (size_t)cur.pn * tstepB;
    S.a_ready(cur);
    if constexpr (SP2) {
        PG8_STAGE(PG8_SB(0, 0), cB, voffB); PG8_STAGE(PG8_SB(0, 1), cB + hstepB, voffB); PG8_STAGE(PG8_SA(0, 0), cA, voffA); PG8_STAGE(PG8_SA(0, 1), cA + hstepA, voffA);
        if (wr == 1) PG8_BAR;
        PG8_WAIT_V(2); PG8_BAR;
        PG8_STAGE(PG8_SB(1, 0), cB + kstep, voffB); PG8_STAGE(PG8_SA(1, 0), cA + kstep, voffA); PG8_STAGE(PG8_SB(1, 1), cB + hstepB + kstep, voffB);
        PG8_WAIT_V(6); PG8_BAR;
    } else {
        PG8_STAGE(PG8_SB(0, 0), cB, voffB); PG8_STAGE(PG8_SA(0, 0), cA, voffA); PG8_STAGE(PG8_SB(0, 1), cB + hstepB, voffB); PG8_STAGE(PG8_SA(0, 1), cA + hstepA, voffA);
        if (wr == 1) PG8_BAR;
        PG8_WAIT_V(4); PG8_BAR;
        PG8_STAGE(PG8_SB(1, 0), cB + kstep, voffB); PG8_STAGE(PG8_SA(1, 0), cA + kstep, voffA); PG8_STAGE(PG8_SB(1, 1), cB + hstepB + kstep, voffB);
        PG8_WAIT_V(6); PG8_BAR;
    }
    for (;;) {
        const bool has_next = S.next(ui + 1, nxt);
        const char* nA = has_next ? (const char*)g.A + (size_t)nxt.pm * tstepA : cA; const char* nB = has_next ? (const char*)g.Bt + (size_t)nxt.pn * tstepB : cB;
        for (int t = 0; t < nt; t += 2) {
            const bool last = (t == nt - 2);
            const char* a1 = cA + (size_t)(t + 1) * kstep;
            const char* a2 = last ? nA : cA + (size_t)(t + 2) * kstep; const char* b2 = last ? nB : cB + (size_t)(t + 2) * kstep;
            const char* a3 = a2 + kstep; const char* b3 = b2 + kstep;
            if (last && has_next) S.a_ready(nxt);
            if constexpr (SP2) {
            PG8_LDB(B0, 0, 0); PG8_LDB(B1, 0, 1); PG8_SCHED; PG8_LDA(At, 0, 0); PG8_STAGE(PG8_SA(1, 1), a1 + hstepA, voffA);
            PG8_WAIT_V(8); PG8_WAIT_L(0); PG8_BAR; PG8_MMA(0, 0, At, B0); PG8_MMA(0, 1, At, B1); PG8_BAR; PG8_SCHED;
            PG8_LDA(At, 0, 1); PG8_STAGE(PG8_SB(0, 0), b2, voffB); PG8_STAGE(PG8_SB(0, 1), b2 + hstepB, voffB); PG8_STAGE(PG8_SA(0, 0), a2, voffA);
            PG8_WAIT_V(8); PG8_WAIT_L(0); PG8_BAR; PG8_MMA(1, 0, At, B0); PG8_MMA(1, 1, At, B1); PG8_BAR; PG8_SCHED;
            PG8_LDB(B0, 1, 0); PG8_LDB(B1, 1, 1); PG8_SCHED; PG8_LDA(At, 1, 0); PG8_STAGE(PG8_SA(0, 1), a2 + hstepA, voffA);
            PG8_WAIT_V(8); PG8_WAIT_L(0); PG8_BAR; PG8_MMA(0, 0, At, B0); PG8_MMA(0, 1, At, B1); PG8_BAR; PG8_SCHED;
            PG8_LDA(At, 1, 1); PG8_STAGE(PG8_SB(1, 0), b3, voffB); PG8_STAGE(PG8_SB(1, 1), b3 + hstepB, voffB); PG8_STAGE(PG8_SA(1, 0), a3, voffA);
            PG8_WAIT_V(8); PG8_WAIT_L(0); PG8_BAR; PG8_MMA(1, 0, At, B0); PG8_MMA(1, 1, At, B1); PG8_BAR; PG8_SCHED;
            } else {
            PG8_LDB(B0, 0, 0); PG8_SCHED; PG8_LDA(At, 0, 0); PG8_STAGE(PG8_SA(1, 1), a1 + hstepA, voffA);
            PG8_WAIT_L(8); PG8_BAR; PG8_WAIT_L(0); PG8_MMA(0, 0, At, B0); PG8_BAR; PG8_SCHED;
            PG8_LDB(B1, 0, 1); PG8_STAGE(PG8_SB(0, 0), b2, voffB);
            PG8_BAR; PG8_WAIT_L(0); PG8_MMA(0, 1, At, B1); PG8_BAR;
            PG8_LDA(At, 0, 1); PG8_STAGE(PG8_SA(0, 0), a2, voffA);
            PG8_BAR; PG8_WAIT_L(0); PG8_MMA(1, 0, At, B0); PG8_BAR; PG8_SCHED;
            PG8_STAGE(PG8_SB(0, 1), b2 + hstepB, voffB);
            PG8_WAIT_V(6); PG8_BAR; PG8_MMA(1, 1, At, B1); PG8_BAR;
            PG8_LDB(B0, 1, 0); PG8_SCHED; PG8_LDA(At, 1, 0); PG8_STAGE(PG8_SA(0, 1), a2 + hstepA, voffA);
            PG8_WAIT_L(8); PG8_BAR; PG8_WAIT_L(0); PG8_MMA(0, 0, At, B0); PG8_BAR; PG8_SCHED;
            PG8_LDB(B1, 1, 1); PG8_STAGE(PG8_SB(1, 0), b3, voffB);
            PG8_BAR; PG8_WAIT_L(0); PG8_MMA(0, 1, At, B1); PG8_BAR;
            PG8_LDA(At, 1, 1); PG8_STAGE(PG8_SA(1, 0), a3, voffA);
            PG8_BAR; PG8_WAIT_L(0); PG8_MMA(1, 0, At, B0); PG8_BAR; PG8_SCHED;
            PG8_STAGE(PG8_SB(1, 1), b3 + hstepB, voffB);
            PG8_WAIT_V(6); PG8_BAR; PG8_MMA(1, 1, At, B1); PG8_BAR;
            }
        }
        if constexpr (ALIGN_EPI) { if (wr == 0) PG8_BAR; }
        if constexpr (!Epi::AFTER_DRAIN) { int t2_; asm volatile("v_mbcnt_lo_u32_b32 %0, -1, 0\n\tv_mbcnt_hi_u32_b32 %0, -1, %0" : "=v"(t2_)); const int fr_ = t2_ & 15, fq_ = (t2_ >> 4) & 3; E(acc, cur, wr, wc, fr_, fq_); S.done(cur); }
        if (!has_next) break;
#pragma unroll
        for (int a = 0; a < 2; ++a)
#pragma unroll
            for (int b = 0; b < 2; ++b)
#pragma unroll
                for (int m = 0; m < 4; ++m)
#pragma unroll
                    for (int n = 0; n < 2; ++n) acc[a][b][m][n] = (f32x4){0.f, 0.f, 0.f, 0.f};
        cur = nxt; cA = nA; cB = nB; ++ui;
        if constexpr (ALIGN_EPI) { if (wr == 1) PG8_BAR; }
    }
    PG8_WAIT_V(0);
    if constexpr (!ALIGN_EPI) { if (wr == 0) PG8_BAR; }
    PG8_BAR;
    if constexpr (Epi::AFTER_DRAIN) { E.fused(acc, cur, wr, wc, fr, fq, lds, wid, lane); S.done(cur); }
#undef PG8_SA
#undef PG8_SB
#undef PG8_STAGE
#undef PG8_LDA
#undef PG8_LDB
#undef PG8_MMA
#undef PG8_WAIT_V
#undef PG8_WAIT_L
#undef PG8_BAR
#undef PG8_SCHED
}
}
using pg8::bf16_t; using pg8::bf16x8; using pg8::f32x4; using pg8::u32x4; using pg8::bf2f; using pg8::bflo; using pg8::bfhi; using pg8::cvt_pk_bf16; using pg8::sigmoidf_; using pg8::siluf_; using pg8::hsum4;
typedef float f32x16 __attribute__((ext_vector_type(16)));
typedef unsigned long long u64;
typedef u64 u64x2 __attribute__((ext_vector_type(2)));
typedef unsigned u32x2 __attribute__((ext_vector_type(2)));
#define LAS __attribute__((address_space(3)))
__device__ __forceinline__ int crow(int r, int hi) { return (r & 3) + 8 * (r >> 2) + 4 * hi; }
__device__ __forceinline__ float wave_sum(float v) {
#pragma unroll
    for (int o = 1; o < 64; o <<= 1) v += __shfl_xor(v, o);
    return v;
}

constexpr size_t MiB = 1u << 20;
constexpr size_t WS_LBS = 0;
constexpr size_t WS_BAR = WS_LBS + 16384;
constexpr size_t WS_ROPE = 64 * 1024;
constexpr size_t WS_DLAST = WS_ROPE + (size_t)LP * 16 * 2 * 4;
constexpr size_t WS_SSQ = WS_DLAST + (size_t)16 * NCH * 128 * 4;
constexpr size_t WS_SSQ2 = WS_SSQ + (size_t)MROWS * 16 * 4;
constexpr size_t WS_MISC_END = WS_SSQ2 + (size_t)MROWS * 24 * 4;
constexpr size_t WS_W = 8 * MiB;
static_assert(WS_MISC_END <= WS_W, "misc");
constexpr size_t WO_GU1 = 0, WO_D1 = WO_GU1 + (size_t)5632 * 1024, WO_IN1 = WO_D1 + (size_t)1024 * 2816, WO_G = WO_IN1 + (size_t)2816 * 1024,
                 WO_UQ = WO_G + (size_t)2048 * 1024, WO_K = WO_UQ + (size_t)768 * 384, WO_V = WO_K + (size_t)512 * 256, WO_P2 = WO_V + (size_t)512 * 256,
                 WO_O = WO_P2 + (size_t)2048 * 1024, WO_GU2 = WO_O + (size_t)1024 * 1024, WO_D2 = WO_GU2 + (size_t)5632 * 1024, WO_END = WO_D2 + (size_t)1024 * 2816;
constexpr size_t WS_H = WS_W + 50 * MiB;
static_assert(WO_END * 2 <= 50 * MiB, "weights");
constexpr size_t WS_HB = WS_H + (size_t)MROWS * DM * 4;
constexpr size_t WS_R2 = WS_HB + (size_t)MROWS * DM * 2;
constexpr size_t WS_R1 = WS_R2 + (size_t)MROWS * 2048 * 2;
constexpr size_t WS_S = WS_R1 + (size_t)MROWS * DM * 2;
constexpr size_t WS_END = WS_S + (size_t)16 * 128 * 128 * 128 * 2;
static_assert(WS_END <= 512 * MiB, "workspace map");
constexpr size_t DO_Q = 0, DO_KN = DO_Q + (size_t)MROWS * 768 * 2, DO_VT = DO_KN + (size_t)MROWS * 512 * 2, DO_KR = DO_VT + (size_t)MROWS * 512 * 2, DO_END = DO_KR + (size_t)MROWS * 32 * 2;
static_assert(DO_END <= (size_t)NBATCH * SEQ * DM * 4 && (size_t)MROWS * DM * 2 <= DO_VT, "d_out scratch map");

struct Args { const float* in[20]; float* out; unsigned char* ws; };
typedef const __attribute__((address_space(4))) Args* cargs_t;
__device__ __forceinline__ cargs_t launder_args(cargs_t p) { asm volatile("" : "+s"(p)); return p; }
#define ARGS_HERE const __attribute__((address_space(4))) Args& a = *launder_args(ap);

__device__ __forceinline__ void cvt_item(const float* src, int Ns, int scol0, int k0, bf16_t* dst, int Kd, int drow0, int kofs, const float* scale, LAS float* scr, int lane) {
#pragma unroll 8
    for (int i = 0; i < 32; ++i) { const int kk = 2 * i + (lane >> 5); float v = src[(size_t)(k0 + kk) * Ns + scol0 + (lane & 31)]; if (scale) v *= scale[k0 + kk]; scr[kk * 33 + (lane & 31)] = v; }
    asm volatile("s_waitcnt lgkmcnt(0)" ::: "memory");
    const int c = lane & 7;
#pragma unroll
    for (int j = 0; j < 4; ++j) { const int n = (lane >> 3) + 8 * j; const LAS float* s = scr + (8 * c) * 33 + n;
        u32x4 o; o.x = cvt_pk_bf16(s[0 * 33], s[1 * 33]); o.y = cvt_pk_bf16(s[2 * 33], s[3 * 33]); o.z = cvt_pk_bf16(s[4 * 33], s[5 * 33]); o.w = cvt_pk_bf16(s[6 * 33], s[7 * 33]);
        *(u32x4*)(dst + (size_t)(drow0 + n) * Kd + kofs + k0 + 8 * c) = o; }
    asm volatile("s_waitcnt lgkmcnt(0)" ::: "memory");
}
__device__ __forceinline__ void cvt_job(const float* src, int Ks, int Ns, const float* scale, bf16_t* dst, int Kd, int nblk, int mode, int soff, int doff, LAS float* scr, int gw, int NGW, int lane) {
    const int nitems = (Ks / 64) * nblk;
    for (int it = gw; it < nitems; it += NGW) { const int kb = it / nblk, nb = it % nblk; int scol0, drow0, kofs = 0;
        if (mode == 0) { scol0 = soff + 32 * nb; drow0 = doff + 32 * nb; }
        else if (mode == 1) { drow0 = 32 * nb; const int pn = drow0 >> 8, w = drow0 & 255; scol0 = (w < 128) ? 128 * pn + w : DFF + 128 * pn + (w - 128); }
        else if (mode == 2) { drow0 = 32 * nb; scol0 = 128 * (drow0 >> 6) + soff + (drow0 & 63); }
        else { const int c0 = 32 * nb; scol0 = c0; drow0 = 256 * (c0 >> 7) + (c0 & 127) + 128 * soff; kofs = 512 * soff; }
        cvt_item(src, Ns, scol0, 64 * kb, dst, Kd, drow0, kofs, scale, scr, lane); }
}
__device__ __forceinline__ void convert_layer(cargs_t ap, int l, unsigned char* lds, int wv_, int grp, int wg0) { ARGS_HERE
    if (bid() < wg0) return;
    int tid_ = TIDX; asm volatile("" : "+v"(tid_)); const int tid = tid_, lane = tid & 63, wave = tid >> 6;
    LAS float* scr = (LAS float*)(LAS unsigned char*)lds + wave * 2176;
    const int gw = (bid() - wg0) * 8 + wave, NGW = (gdim() - wg0) * 8;
    bf16_t* W = (bf16_t*)(a.ws + WS_W);
    const float* ffn1_norm = a.in[2] + (size_t)l * DM; const float* ffn1_gu = a.in[3] + (size_t)l * DM * 5632; const float* ffn1_dn = a.in[4] + (size_t)l * DFF * DM;
    const float* mix_norm = a.in[5] + (size_t)l * DM; const float* w_in = a.in[6] + (size_t)l * DM * DIN; const float* q_norm = a.in[7] + (size_t)l * 384; const float* kv_norm = a.in[8] + (size_t)l * 256;
    const float* w_uq = a.in[9] + (size_t)l * 384 * 768; const float* w_ukv = a.in[10] + (size_t)l * 256 * 1024;
    const float* w_pa = a.in[13] + (size_t)l * 512 * DM; const float* w_pr = a.in[14] + (size_t)l * 512 * DM; const float* w_o = a.in[15] + (size_t)l * DM * DM;
    const float* ffn2_norm = a.in[16] + (size_t)l * DM; const float* ffn2_gu = a.in[17] + (size_t)l * DM * 5632; const float* ffn2_dn = a.in[18] + (size_t)l * DFF * DM;
    if (grp & 1) {
    cvt_job(ffn1_gu, 1024, 5632, ffn1_norm, W + WO_GU1, 1024, 176, 1, 0, 0, scr, gw, NGW, lane);
    }
    if (grp & 2) {
    cvt_job(ffn1_dn, 2816, 1024, nullptr, W + WO_D1, 2816, 32, 0, 0, 0, scr, gw, NGW, lane);
    cvt_job(w_in, 1024, DIN, mix_norm, W + WO_IN1, 1024, 21, 0, 0, 0, scr, gw, NGW, lane);
    cvt_job(w_in, 1024, DIN, mix_norm, W + WO_IN1, 1024, 64, 0, 672, 768, scr, gw, NGW, lane);
    cvt_job(w_in, 1024, DIN, mix_norm, W + WO_G, 1024, 64, 0, 2720, 0, scr, gw, NGW, lane);
    cvt_job(w_uq, 384, 768, q_norm, W + WO_UQ, 384, 24, 0, 0, 0, scr, gw, NGW, lane);
    cvt_job(w_ukv, 256, 1024, kv_norm, W + WO_K, 256, 16, 2, 0, 0, scr, gw, NGW, lane);
    cvt_job(w_ukv, 256, 1024, kv_norm, W + WO_V, 256, 16, 2, 64, 0, scr, gw, NGW, lane);
    cvt_job(w_pa, 512, 1024, nullptr, W + WO_P2, 1024, 32, 3, 0, 0, scr, gw, NGW, lane);
    cvt_job(w_pr, 512, 1024, nullptr, W + WO_P2, 1024, 32, 3, 1, 0, scr, gw, NGW, lane);
    cvt_job(w_o, 1024, 1024, nullptr, W + WO_O, 1024, 32, 0, 0, 0, scr, gw, NGW, lane);
    cvt_job(ffn2_gu, 1024, 5632, ffn2_norm, W + WO_GU2, 1024, 176, 1, 0, 0, scr, gw, NGW, lane);
    }
    if (grp & 4) {
    cvt_job(ffn2_dn, 2816, 1024, nullptr, W + WO_D2, 2816, 32, 0, 0, 0, scr, gw, NGW, lane);
    }
    if (grp & 2) {
    const int gt = (bid() - wg0) * 512 + tid, NGT = (gdim() - wg0) * 512; unsigned zz_ = 0u; asm volatile("" : "+v"(zz_)); const u32x4 z = {zz_, zz_, zz_, zz_};
    for (int i = gt; i < 96 * 128; i += NGT) *(u32x4*)(W + WO_IN1 + (size_t)672 * 1024 + (size_t)i * 8) = z;
    for (int i = gt; i < 2048 * 64; i += NGT) { const int r = i >> 6, c = i & 63; const int half = ((r & 255) < 128) ? 1 : 0; *(u32x4*)(W + WO_P2 + (size_t)r * 1024 + half * 512 + c * 8) = z; }
    }
}

__device__ __forceinline__ void init_phase(cargs_t ap, int wv_) { ARGS_HERE
    int tid_ = TIDX; asm volatile("" : "+v"(tid_)); const int tid = tid_, lane = tid & 63, wave = tid >> 6;
    const int gw = bid() * 8 + wave, NGW = gdim() * 8;
    bf16_t* hb = (bf16_t*)(a.ws + WS_HB); float* ssq = (float*)(a.ws + WS_SSQ);
    for (int r = gw; r < MROWS; r += NGW) { const int b = r / LP, p = r % LP;
        const float* src = (p < FRONT) ? nullptr : (p < 64 ? a.in[1] + (size_t)(p - FRONT) * DM : a.in[0] + ((size_t)b * SEQ + (p - 64)) * DM);
        float s = 0.f;
#pragma unroll
        for (int j = 0; j < 4; ++j) { f32x4 v = {0.f, 0.f, 0.f, 0.f}; if (src) v = *(const f32x4*)(src + 256 * j + 4 * lane);
            u32x2 w; w.x = cvt_pk_bf16(v[0], v[1]); w.y = cvt_pk_bf16(v[2], v[3]);
            *(u32x2*)(hb + (size_t)r * DM + 256 * j + 4 * lane) = w; s += hsum4(v * v); }
        s = wave_sum(s);
        if (lane < 16) ssq[(size_t)r * 16 + lane] = (lane == 0) ? s : 0.f; }
    const int gt = bid() * 512 + tid, NGT = gdim() * 512;
    float* lbs = (float*)(a.ws + WS_LBS); const float* raw = a.in[11];
    for (int c = gt; c < 512; c += NGT) { const float r0 = raw[c], r1 = raw[512 + c], r2 = raw[1024 + c], r3 = raw[1536 + c]; const float mx = fmaxf(fmaxf(r0, r1), fmaxf(r2, r3));
        const float e0 = __expf(r0 - mx), e1 = __expf(r1 - mx), e2 = __expf(r2 - mx), e3 = __expf(r3 - mx); const float inv = 1.f / (e0 + e1 + e2 + e3);
        lbs[c] = 0.f; lbs[512 + c] = e1 * inv; lbs[1024 + c] = (e1 + e2) * inv; lbs[1536 + c] = (e1 + e2 + e3) * inv; }
    float* rope = (float*)(a.ws + WS_ROPE);
    for (int i = gt; i < LP * 16; i += NGT) { const int p = i >> 4, j = i & 15; const int pos = p < FRONT ? 0 : p - FRONT;
        const float inv = powf(10000.0f, -(float)j / 16.0f); const float ang = (float)pos * inv;
        double t = (double)ang * 0.15915494309189535; t -= floor(t); const float tf = (float)t;
        rope[2 * i] = __builtin_amdgcn_cosf(tf); rope[2 * i + 1] = __builtin_amdgcn_sinf(tf); }
}
constexpr int AK_P = 104, AV_P = 68, AK_BUF = 64 * AK_P, AV_BUF = 64 * AV_P;
__device__ __forceinline__ void attn_tile(const bf16_t* Kt, const bf16_t* Vt_, const bf16x8 (&qf)[6], f32x16& o0, f32x16& o1, float& m_run, float& l_run, int kv0, int qw, int qrow, int r32, int hi, bool first) {
    if (kv0 > qw + 31) return;
    f32x16 p0, p1;
#pragma unroll
    for (int r = 0; r < 16; ++r) { p0[r] = 0.f; p1[r] = 0.f; }
    const bf16_t* kb = Kt + r32 * AK_P + 8 * hi;
#pragma unroll
    for (int j = 0; j < 6; ++j) { const bf16x8 k0 = *(const bf16x8*)(kb + 16 * j), k1 = *(const bf16x8*)(kb + 32 * AK_P + 16 * j);
        p0 = __builtin_amdgcn_mfma_f32_32x32x16_bf16(k0, qf[j], p0, 0, 0, 0); p1 = __builtin_amdgcn_mfma_f32_32x32x16_bf16(k1, qf[j], p1, 0, 0, 0); }
    if (kv0 + 63 > qw || first) {
#pragma unroll
        for (int r = 0; r < 16; ++r) { const int kv = kv0 + crow(r, hi); if (kv > qrow || kv < FRONT) p0[r] = -1e30f; if (kv + 32 > qrow || kv + 32 < FRONT) p1[r] = -1e30f; }
    }
    float mx = fmaxf(p0[0], p1[0]);
#pragma unroll
    for (int r = 1; r < 16; ++r) mx = fmaxf(mx, fmaxf(p0[r], p1[r]));
    { const auto rr_ = __builtin_amdgcn_permlane32_swap(__float_as_uint(mx), __float_as_uint(mx), false, false); mx = fmaxf(__uint_as_float(rr_[0]), __uint_as_float(rr_[1])); }
    const float m_new = fmaxf(m_run, mx); const float alpha = __builtin_amdgcn_exp2f(m_run - m_new); m_run = m_new;
    float rs = 0.f;
#pragma unroll
    for (int r = 0; r < 16; ++r) { p0[r] = __builtin_amdgcn_exp2f(p0[r] - m_new); p1[r] = __builtin_amdgcn_exp2f(p1[r] - m_new); rs += p0[r] + p1[r]; }
    l_run = l_run * alpha + rs;
    if (__any(alpha != 1.f)) {
#pragma unroll
        for (int r = 0; r < 16; ++r) { o0[r] *= alpha; o1[r] *= alpha; } }
    u32x4 pw[4];
#pragma unroll
    for (int s = 0; s < 2; ++s) {
        pw[s] = (u32x4){cvt_pk_bf16(p0[8 * s], p0[8 * s + 1]), cvt_pk_bf16(p0[8 * s + 2], p0[8 * s + 3]), cvt_pk_bf16(p0[8 * s + 4], p0[8 * s + 5]), cvt_pk_bf16(p0[8 * s + 6], p0[8 * s + 7])};
        pw[2 + s] = (u32x4){cvt_pk_bf16(p1[8 * s], p1[8 * s + 1]), cvt_pk_bf16(p1[8 * s + 2], p1[8 * s + 3]), cvt_pk_bf16(p1[8 * s + 4], p1[8 * s + 5]), cvt_pk_bf16(p1[8 * s + 6], p1[8 * s + 7])}; }
    const bf16_t* vb = Vt_ + r32 * AV_P + 4 * hi;
#pragma unroll
    for (int s = 0; s < 4; ++s) { const int kvo = 32 * (s >> 1) + 16 * (s & 1); const bf16x8 pa = __builtin_bit_cast(bf16x8, pw[s]);
        { const u64 a0 = *(const u64*)(vb + kvo), a1 = *(const u64*)(vb + kvo + 8); const bf16x8 vf = __builtin_bit_cast(bf16x8, (u64x2){a0, a1}); o0 = __builtin_amdgcn_mfma_f32_32x32x16_bf16(vf, pa, o0, 0, 0, 0); }
        { const u64 a0 = *(const u64*)(vb + 32 * AV_P + kvo), a1 = *(const u64*)(vb + 32 * AV_P + kvo + 8); const bf16x8 vf = __builtin_bit_cast(bf16x8, (u64x2){a0, a1}); o1 = __builtin_amdgcn_mfma_f32_32x32x16_bf16(vf, pa, o1, 0, 0, 0); } }
}
__device__ __forceinline__ void attn_unit(unsigned char* lds, const bf16_t* Q, const bf16_t* KN, const bf16_t* KR, const bf16_t* VT, bf16_t* AO, int b, int h, int q0, int NT, int nstore, int wv_) {
    int tid_ = TIDX; asm volatile("" : "+v"(tid_)); const int tid = tid_, lane = tid & 63, w = tid >> 6, r32 = lane & 31, hi = lane >> 5;
    bf16_t* Ks = (bf16_t*)lds; bf16_t* Vs = (bf16_t*)(lds + 2 * AK_BUF * 2);
    const int qw = q0 + 32 * w, qrow = qw + r32;
    const size_t rowb = (size_t)b * LP;
    bf16x8 qf[6];
    { const bf16_t* qp = Q + (rowb + qrow) * 768 + h * 96 + 8 * hi;
#pragma unroll
      for (int j = 0; j < 6; ++j) qf[j] = *(const bf16x8*)(qp + 16 * j); }
    f32x16 o0, o1;
#pragma unroll
    for (int r = 0; r < 16; ++r) { o0[r] = 0.f; o1[r] = 0.f; }
    float m_run = -1e30f, l_run = 0.f;
    const int lrow = tid >> 3, lch = tid & 7;
    const bf16_t* kn_p = KN + (rowb + lrow) * 512 + h * 64 + lch * 8;
    const bf16_t* vt_p = VT + (size_t)(h * 64 + lrow) * MROWS + rowb + lch * 8;
    const bf16_t* kr_p = KR + (rowb + (tid >> 2)) * 32 + (tid & 3) * 8;
    u32x4 rk0, rv0, rr0 = {0u, 0u, 0u, 0u}, rk1, rv1, rr1 = {0u, 0u, 0u, 0u};
#define A_GLOAD(t, S) do { rk##S = *(const u32x4*)(kn_p + (size_t)(t) * 64 * 512); rv##S = *(const u32x4*)(vt_p + (size_t)(t) * 64); if (tid < 256) rr##S = *(const u32x4*)(kr_p + (size_t)(t) * 64 * 32); } while (0)
#define A_LSTORE(buf, S) do { *(u32x4*)(Ks + (buf) * AK_BUF + lrow * AK_P + lch * 8) = rk##S; if (tid < 256) *(u32x4*)(Ks + (buf) * AK_BUF + (tid >> 2) * AK_P + 64 + (tid & 3) * 8) = rr##S; \
        u32x2 lo_ = {rv##S.x, rv##S.y}, hi_ = {rv##S.z, rv##S.w}; *(u32x2*)(Vs + (buf) * AV_BUF + lrow * AV_P + lch * 8) = lo_; *(u32x2*)(Vs + (buf) * AV_BUF + lrow * AV_P + lch * 8 + 4) = hi_; } while (0)
    A_GLOAD(0, 0); if (NT > 1) A_GLOAD(1, 1);
    A_LSTORE(0, 0); __syncthreads();
    for (int t = 0; t < NT; t += 2) {
        if (t + 2 < NT) A_GLOAD(t + 2, 0);
        attn_tile(Ks, Vs, qf, o0, o1, m_run, l_run, 64 * t, qw, qrow, r32, hi, t == 0);
        if (t + 1 < NT) A_LSTORE(1, 1);
        __syncthreads();
        if (t + 1 < NT) {
            if (t + 3 < NT) A_GLOAD(t + 3, 1);
            attn_tile(Ks + AK_BUF, Vs + AV_BUF, qf, o0, o1, m_run, l_run, 64 * (t + 1), qw, qrow, r32, hi, false);
            if (t + 2 < NT) A_LSTORE(0, 0);
            __syncthreads();
        }
    }
#undef A_GLOAD
#undef A_LSTORE
    const float lt = l_run + __shfl_xor(l_run, 32); const float inv = 1.f / lt;
    if (w < nstore) { bf16_t* op = AO + (rowb + qrow) * DM + h * 64 + 4 * hi;
#pragma unroll
        for (int g = 0; g < 4; ++g) { u32x2 a, c; a.x = cvt_pk_bf16(o0[4 * g] * inv, o0[4 * g + 1] * inv); a.y = cvt_pk_bf16(o0[4 * g + 2] * inv, o0[4 * g + 3] * inv);
            c.x = cvt_pk_bf16(o1[4 * g] * inv, o1[4 * g + 1] * inv); c.y = cvt_pk_bf16(o1[4 * g + 2] * inv, o1[4 * g + 3] * inv);
            *(u32x2*)(op + 8 * g) = a; *(u32x2*)(op + 32 + 8 * g) = c; } }
}
__device__ __forceinline__ void attn_phase(unsigned char* lds, cargs_t ap, int part, int wv_) { ARGS_HERE
    const bf16_t* Q = (const bf16_t*)((unsigned char*)a.out + DO_Q); const bf16_t* KN = (const bf16_t*)((unsigned char*)a.out + DO_KN);
    const bf16_t* VT = (const bf16_t*)((unsigned char*)a.out + DO_VT); const bf16_t* KR = (const bf16_t*)((unsigned char*)a.out + DO_KR);
    bf16_t* AO = (bf16_t*)(a.ws + WS_R1);
    for (int vv = bid(); vv < 256; vv += gdim()) { const int v = (vv & 7) * 32 + (vv >> 3);
        const int bh = v >> 3, s = v & 7, b = bh >> 3, h = bh & 7;
        if (part == 0 && s == 0) attn_unit(lds, Q, KN, KR, VT, AO, b, h, 0, 1, 2, wv_);
#pragma unroll 1
        for (int i = 0; i < 2; ++i) { const int blk = part == 0 ? (i == 0 ? s : 15 - s) : (i == 0 ? 16 + s : 31 - s);
            attn_unit(lds, Q, KN, KR, VT, AO, b, h, 64 + 256 * blk, 4 * blk + 5, 8, wv_); } }
}
__device__ __forceinline__ unsigned short f2bf_(float f) { return (unsigned short)(cvt_pk_bf16(f, 0.f) & 0xffffu); }
#define HG_GATES(hg4p, r0, hh, lb) \
    float bq[16], kk[16]; float total, hg_pre, hg_b1, hg_b2, hg_b3; { const float oml = 1.f - (lb); float run = 0.f; \
        _Pragma("unroll") for (int i = 0; i < 16; ++i) { const float z = bf2f((hg4p)[(size_t)((r0) + 16 * sq + i) * 2048 + 512 + (hh) * 128 + k]); const float sg = sigmoidf_(z); \
            const float f = (lb) + oml * sg; run += __logf(fmaxf(f, 1e-20f)); bq[i] = run; kk[i] = oml * (1.f - sg); } \
        part[sq * 128 + k] = run; __syncthreads(); \
        const float t0 = part[k], t1 = part[128 + k], t2 = part[256 + k], t3 = part[384 + k]; total = (t0 + t1) + (t2 + t3); \
        const float pre = (sq > 0 ? t0 : 0.f) + (sq > 1 ? t1 : 0.f) + (sq > 2 ? t2 : 0.f); \
        hg_pre = pre; hg_b1 = t0; hg_b2 = t0 + t1; hg_b3 = (t0 + t1) + t2; \
        _Pragma("unroll") for (int i = 0; i < 16; ++i) bq[i] += pre; }

__device__ __forceinline__ void hgrn_h1(unsigned char* lds, cargs_t ap, int l, int wv_) { ARGS_HERE
    int tid_ = TIDX; asm volatile("" : "+v"(tid_)); const int tid = tid_, lane = tid & 63, w = tid >> 6, k = tid & 127, sq = tid >> 7, fr = lane & 15, fq = lane >> 4;
    bf16_t* kdT = (bf16_t*)lds;
    bf16_t* vT = (bf16_t*)(lds + 18432);
    float* part = (float*)(lds + 36864);
    const bf16_t* hg4 = (const bf16_t*)(a.ws + WS_R2); const float* lbs = (const float*)(a.ws + WS_LBS) + l * 512;
    float* dlast = (float*)(a.ws + WS_DLAST); bf16_t* S = (bf16_t*)(a.ws + WS_S);
    for (int u = bid(); u < 16 * 128; u += gdim()) { const int bh = u >> 7, c = u & 127, b = bh >> 2, hh = bh & 3; const int r0 = b * LP + 64 * c;
        const float lb = lbs[hh * 128 + k];
        HG_GATES(hg4, r0, hh, lb)
        unsigned kw[8], vw[8];
#pragma unroll
        for (int i = 0; i < 8; ++i) { const float d0 = kk[2 * i] * __expf(total - bq[2 * i]), d1 = kk[2 * i + 1] * __expf(total - bq[2 * i + 1]); kw[i] = cvt_pk_bf16(d0, d1);
            const unsigned v0 = hg4[(size_t)(r0 + 16 * sq + 2 * i) * 2048 + 1024 + hh * 128 + k], v1 = hg4[(size_t)(r0 + 16 * sq + 2 * i + 1) * 2048 + 1024 + hh * 128 + k]; vw[i] = v0 | (v1 << 16); }
        *(u32x4*)(kdT + k * 72 + 16 * sq) = (u32x4){kw[0], kw[1], kw[2], kw[3]}; *(u32x4*)(kdT + k * 72 + 16 * sq + 8) = (u32x4){kw[4], kw[5], kw[6], kw[7]};
        *(u32x4*)(vT + k * 72 + 16 * sq) = (u32x4){vw[0], vw[1], vw[2], vw[3]}; *(u32x4*)(vT + k * 72 + 16 * sq + 8) = (u32x4){vw[4], vw[5], vw[6], vw[7]};
        if (sq == 0) dlast[((size_t)bh * NCH + c) * 128 + k] = __expf(total);
        __syncthreads();
        bf16x8 yv[2];
#pragma unroll
        for (int ks = 0; ks < 2; ++ks) yv[ks] = *(const bf16x8*)(vT + (16 * w + fr) * 72 + 32 * ks + 8 * fq);
        bf16_t* Sd = S + ((size_t)(bh * 128 + c) * 128 + 16 * w + fr) * 128 + 4 * fq;
#pragma unroll
        for (int kb = 0; kb < 8; ++kb) { f32x4 acc = {0.f, 0.f, 0.f, 0.f};
#pragma unroll
            for (int ks = 0; ks < 2; ++ks) { const bf16x8 xk = *(const bf16x8*)(kdT + (16 * kb + fr) * 72 + 32 * ks + 8 * fq); acc = __builtin_amdgcn_mfma_f32_16x16x32_bf16(xk, yv[ks], acc, 0, 0, 0); }
            u32x2 o; o.x = cvt_pk_bf16(acc[0], acc[1]); o.y = cvt_pk_bf16(acc[2], acc[3]); *(u32x2*)(Sd + 16 * kb) = o; }
        __syncthreads(); }
}
__device__ __forceinline__ void hgrn_h2(cargs_t ap, int wv_) { ARGS_HERE
    const float* dlast = (const float*)(a.ws + WS_DLAST); unsigned* S = (unsigned*)(a.ws + WS_S);
    for (int g = bid() * 512 + TIDX; g < 16 * 128 * 64; g += gdim() * 512) { const int bh = g >> 13, rem = g & 8191, v = rem >> 6, kp = rem & 63;
        unsigned* sp = S + (((size_t)bh * 128) * 128 + v) * 64 + kp; const float* dp = dlast + (size_t)bh * NCH * 128 + 2 * kp;
        float s0 = 0.f, s1 = 0.f;
        for (int c0 = 0; c0 < 128; c0 += 8) { unsigned loc[8]; float d0[8], d1[8];
#pragma unroll
            for (int j = 0; j < 8; ++j) { loc[j] = sp[(size_t)(c0 + j) * 128 * 64]; const float2 d = *(const float2*)(dp + (size_t)(c0 + j) * 128); d0[j] = d.x; d1[j] = d.y; }
#pragma unroll
            for (int j = 0; j < 8; ++j) { s0 = d0[j] * s0 + bflo(loc[j]); s1 = d1[j] * s1 + bfhi(loc[j]); sp[(size_t)(c0 + j) * 128 * 64] = cvt_pk_bf16(s0, s1); } } }
}
__device__ __forceinline__ void hgrn_h3(unsigned char* lds, cargs_t ap, int l, int wv_) { ARGS_HERE
    int tid_ = TIDX; asm volatile("" : "+v"(tid_)); const int tid = tid_, lane = tid & 63, w = tid >> 6, k = tid & 127, sq = tid >> 7, fr = lane & 15, fq = lane >> 4;
    float* bF = (float*)lds;
    bf16_t* qB = (bf16_t*)(lds + 33792);
    bf16_t* kB = (bf16_t*)(lds + 51200);
    bf16_t* qdB = (bf16_t*)(lds + 68608);
    bf16_t* vT = (bf16_t*)(lds + 86016);
    float* Ap = (float*)(lds + 104448);
    float* part = (float*)(lds + 137216);
    bf16_t* Ab = qB; bf16_t* KdB = (bf16_t*)lds; bf16_t* QdB = (bf16_t*)(lds + 104448);
    const bf16_t* hg4 = (const bf16_t*)(a.ws + WS_R2); const float* lbs = (const float*)(a.ws + WS_LBS) + l * 512; const float* normw = a.in[12] + (size_t)l * 128;
    const bf16_t* S = (const bf16_t*)(a.ws + WS_S); bf16_t* RO = (bf16_t*)(a.ws + WS_R1);
    for (int u = bid(); u < 16 * NCH; u += gdim()) { const int bh = u / NCH, c = u % NCH, b = bh >> 2, hh = bh & 3; const int r0 = b * LP + 64 * c;
        const float lb = lbs[hh * 128 + k];
        HG_GATES(hg4, r0, hh, lb)
        float qv[16];
        { unsigned vw[8];
#pragma unroll
          for (int i = 0; i < 16; ++i) { const int t = 16 * sq + i; bF[t * 132 + k] = bq[i]; kB[t * 136 + k] = f2bf_(kk[i]);
              qv[i] = siluf_(bf2f(hg4[(size_t)(r0 + t) * 2048 + hh * 128 + k])); qB[t * 136 + k] = f2bf_(qv[i]); qdB[t * 136 + k] = f2bf_(qv[i] * __expf(bq[i]) * HG_SCALE); }
#pragma unroll
          for (int i = 0; i < 8; ++i) { const unsigned v0 = hg4[(size_t)(r0 + 16 * sq + 2 * i) * 2048 + 1024 + hh * 128 + k], v1 = hg4[(size_t)(r0 + 16 * sq + 2 * i + 1) * 2048 + 1024 + hh * 128 + k]; vw[i] = v0 | (v1 << 16); }
          *(u32x4*)(vT + k * 72 + 16 * sq) = (u32x4){vw[0], vw[1], vw[2], vw[3]}; *(u32x4*)(vT + k * 72 + 16 * sq + 8) = (u32x4){vw[4], vw[5], vw[6], vw[7]}; }
        __syncthreads();
        { const int c4 = tid >> 7, blk = (tid >> 3) & 15, tb = blk >> 2, sb = blk & 3, kh = tid & 7;
          if (sb <= tb) { f32x4 ac[4];
#pragma unroll
              for (int i = 0; i < 4; ++i) ac[i] = (f32x4){0.f, 0.f, 0.f, 0.f};
              const int t0 = 16 * c4 + 4 * tb, s0 = 16 * c4 + 4 * sb;
#pragma unroll 1
              for (int k4 = 0; k4 < 4; ++k4) { const int kb = 16 * kh + 4 * k4; f32x4 bs[4], ks[4];
#pragma unroll
                  for (int j = 0; j < 4; ++j) { bs[j] = *(const f32x4*)(bF + (s0 + j) * 132 + kb); const u32x2 kw = *(const u32x2*)(kB + (s0 + j) * 136 + kb);
                      ks[j] = (f32x4){bflo(kw.x), bfhi(kw.x), bflo(kw.y), bfhi(kw.y)}; }
#pragma unroll
                  for (int i = 0; i < 4; ++i) { const f32x4 bt = *(const f32x4*)(bF + (t0 + i) * 132 + kb); const u32x2 qw = *(const u32x2*)(qB + (t0 + i) * 136 + kb);
                      const f32x4 qt = {bflo(qw.x), bfhi(qw.x), bflo(qw.y), bfhi(qw.y)};
#pragma unroll
                      for (int j = 0; j < 4; ++j)
#pragma unroll
                          for (int e = 0; e < 4; ++e) { const float d = fminf(bt[e] - bs[j][e], 0.f); ac[i][j] += qt[e] * ks[j][e] * __builtin_amdgcn_exp2f(d * 1.4426950408889634f); }
                      __builtin_amdgcn_sched_barrier(0); } }
#pragma unroll
              for (int i = 0; i < 4; ++i) *(f32x4*)(Ap + kh * 1024 + (t0 + i) * 16 + 4 * sb) = ac[i]; } }
        __syncthreads();
        { const int t = tid >> 3, s0 = (tid & 7) * 8; const int dsub = (s0 >> 4) - (t >> 4);
          if (dsub >= 0) { float v[8];
#pragma unroll
              for (int e = 0; e < 8; ++e) { const int s = s0 + e; float x = 0.f;
                  if (dsub == 0) {
#pragma unroll
                      for (int q8 = 0; q8 < 8; ++q8) x += Ap[q8 * 1024 + t * 16 + (s & 15)]; }
                  v[e] = (dsub == 0 && s <= t) ? x * HG_SCALE : 0.f; }
              *(u32x4*)(Ab + t * 72 + s0) = (u32x4){cvt_pk_bf16(v[0], v[1]), cvt_pk_bf16(v[2], v[3]), cvt_pk_bf16(v[4], v[5]), cvt_pk_bf16(v[6], v[7])}; } }
        __syncthreads();
        { if (sq >= 1) {
#pragma unroll
              for (int i = 0; i < 16; ++i) QdB[(16 * (sq - 1) + i) * 136 + k] = f2bf_(qv[i] * __expf(bq[i] - hg_pre)); }
#pragma unroll
          for (int ti = 1; ti < 4; ++ti) { if (ti > sq) { const float Bi = ti == 1 ? hg_b1 : (ti == 2 ? hg_b2 : hg_b3); const int roff = ti == 1 ? 0 : (ti == 2 ? 16 : 48);
#pragma unroll
                  for (int i = 0; i < 16; ++i) KdB[(roff + 16 * sq + i) * 136 + k] = f2bf_(kk[i] * __expf(Bi - bq[i])); } } }
        __syncthreads();
        if (w < 6) { const int ti = w == 0 ? 1 : (w < 3 ? 2 : 3), tj = w == 0 ? 0 : (w < 3 ? w - 1 : w - 3); const int roff = ti == 1 ? 0 : (ti == 2 ? 16 : 48);
            f32x4 acc = {0.f, 0.f, 0.f, 0.f};
#pragma unroll
            for (int ks = 0; ks < 4; ++ks) { const bf16x8 xk = *(const bf16x8*)(KdB + (roff + 16 * tj + fr) * 136 + 32 * ks + 8 * fq), yq = *(const bf16x8*)(QdB + (16 * (ti - 1) + fr) * 136 + 32 * ks + 8 * fq);
                acc = __builtin_amdgcn_mfma_f32_16x16x32_bf16(xk, yq, acc, 0, 0, 0); }
            u32x2 o; o.x = cvt_pk_bf16(acc[0] * HG_SCALE, acc[1] * HG_SCALE); o.y = cvt_pk_bf16(acc[2] * HG_SCALE, acc[3] * HG_SCALE);
            *(u32x2*)(Ab + (16 * ti + fr) * 72 + 16 * tj + 4 * fq) = o; }
        __syncthreads();
        { const int tb = w & 3, vh = w >> 2; f32x4 acc[4];
#pragma unroll
          for (int nb = 0; nb < 4; ++nb) acc[nb] = (f32x4){0.f, 0.f, 0.f, 0.f};
          if (c > 0) { const bf16_t* Sp = S + ((size_t)(bh * 128 + (c - 1)) * 128 + 64 * vh + fr) * 128 + 8 * fq;
#pragma unroll
              for (int ks = 0; ks < 4; ++ks) { const bf16x8 yq = *(const bf16x8*)(qdB + (16 * tb + fr) * 136 + 32 * ks + 8 * fq);
#pragma unroll
                  for (int nb = 0; nb < 4; ++nb) { const bf16x8 xs = *(const bf16x8*)(Sp + (size_t)nb * 16 * 128 + 32 * ks); acc[nb] = __builtin_amdgcn_mfma_f32_16x16x32_bf16(xs, yq, acc[nb], 0, 0, 0); } } }
#pragma unroll
          for (int ks = 0; ks < 2; ++ks) { const bf16x8 ya = *(const bf16x8*)(Ab + (16 * tb + fr) * 72 + 32 * ks + 8 * fq);
#pragma unroll
              for (int nb = 0; nb < 4; ++nb) { const bf16x8 xv = *(const bf16x8*)(vT + (64 * vh + 16 * nb + fr) * 72 + 32 * ks + 8 * fq); acc[nb] = __builtin_amdgcn_mfma_f32_16x16x32_bf16(xv, ya, acc[nb], 0, 0, 0); } }
          float ss = 0.f;
#pragma unroll
          for (int nb = 0; nb < 4; ++nb) ss += hsum4(acc[nb] * acc[nb]);
          ss += __shfl_xor(ss, 16); ss += __shfl_xor(ss, 32);
          if (fq == 0) part[vh * 64 + 16 * tb + fr] = ss;
          __syncthreads();
          const float tot = part[16 * tb + fr] + part[64 + 16 * tb + fr]; const float rn = rsqrtf(tot * (1.f / 128.f) + EPS);
          const int row = r0 + 16 * tb + fr;
#pragma unroll
          for (int nb = 0; nb < 4; ++nb) { const int vcol = 64 * vh + 16 * nb + 4 * fq; const u32x2 gw = *(const u32x2*)(hg4 + (size_t)row * 2048 + 1536 + hh * 128 + vcol); const f32x4 nw = *(const f32x4*)(normw + vcol);
              const float o0 = acc[nb][0] * rn * nw[0] * siluf_(bflo(gw.x)), o1 = acc[nb][1] * rn * nw[1] * siluf_(bfhi(gw.x)), o2 = acc[nb][2] * rn * nw[2] * siluf_(bflo(gw.y)), o3 = acc[nb][3] * rn * nw[3] * siluf_(bfhi(gw.y));
              u32x2 o; o.x = cvt_pk_bf16(o0, o1); o.y = cvt_pk_bf16(o2, o3); *(u32x2*)(RO + (size_t)row * DM + 512 + hh * 128 + vcol) = o; } }
        __syncthreads(); }
}
__device__ __forceinline__ void kr_rope(cargs_t ap, int wv_) { ARGS_HERE
    const bf16_t* zc = (const bf16_t*)(a.ws + WS_R1); bf16_t* kr = (bf16_t*)((unsigned char*)a.out + DO_KR); const float* rope = (const float*)(a.ws + WS_ROPE);
    for (int i = bid() * 512 + TIDX; i < MROWS * 16; i += gdim() * 512) { const int r = i >> 4, j = i & 15, p = r % LP;
        const float x1 = bf2f(zc[(size_t)r * 768 + 640 + j]), x2 = bf2f(zc[(size_t)r * 768 + 656 + j]); const float c = rope[((size_t)p * 16 + j) * 2], s = rope[((size_t)p * 16 + j) * 2 + 1];
        kr[(size_t)r * 32 + j] = f2bf_(x1 * c - x2 * s); kr[(size_t)r * 32 + 16 + j] = f2bf_(x2 * c + x1 * s); }
}
__device__ __forceinline__ void final_phase(cargs_t ap, int wv_) { ARGS_HERE
    const int lane = TIDX & 63, wave = TIDX >> 6; const bf16_t* hb = (const bf16_t*)(a.ws + WS_HB); const float* fw = a.in[19];
    for (int r = bid() * 8 + wave; r < NBATCH * SEQ; r += gdim() * 8) { const int b = r / SEQ, t = r % SEQ; const bf16_t* hp = hb + ((size_t)b * LP + 64 + t) * DM;
        f32x4 v[4]; float s = 0.f;
#pragma unroll
        for (int j = 0; j < 4; ++j) { const u32x2 w = *(const u32x2*)(hp + 256 * j + 4 * lane); v[j] = (f32x4){bflo(w.x), bfhi(w.x), bflo(w.y), bfhi(w.y)}; s += hsum4(v[j] * v[j]); }
        const float rs = rsqrtf(wave_sum(s) * (1.f / 1024.f) + EPS);
#pragma unroll
        for (int j = 0; j < 4; ++j) { const f32x4 wv = *(const f32x4*)(fw + 256 * j + 4 * lane); *(f32x4*)(a.out + (size_t)r * DM + 256 * j + 4 * lane) = v[j] * rs * wv; } }
}

#define XB_TMO      128
#define XB_XCNT(j)  (256  + 64 * (j))
#define XB_XSUB(j)  (1280 + 64 * (j))
#define XB_XGEN(j)  (2304 + 64 * (j))
#define XB_TOP      3328
#define XB_TOPGEN   3392
#define XCD_BAR_WORDS 3456
#define XB_SPIN_CAP (1u << 18)

__device__ __forceinline__ unsigned xb_ld(unsigned* p)              { return __hip_atomic_load(p, __ATOMIC_RELAXED, __HIP_MEMORY_SCOPE_AGENT); }
__device__ __forceinline__ unsigned xb_add(unsigned* p, unsigned v) { return __hip_atomic_fetch_add(p, v, __ATOMIC_RELAXED, __HIP_MEMORY_SCOPE_AGENT); }
__device__ __forceinline__ unsigned xb_xcc_id() { return (unsigned)__builtin_amdgcn_s_getreg((3 << 11) | 20) & 0xFu; }
#define XB_SPIN(cond, bar) do { unsigned _sp = 0; while (cond) { __builtin_amdgcn_s_sleep(1); \
    if ((++_sp & 255u) == 0u) { if (xb_ld(&(bar)[XB_TMO])) break; if (_sp > XB_SPIN_CAP) { atomicAdd(&(bar)[XB_TMO], 1u); break; } } } } while (0)

struct XcdBarrier {
    unsigned* bar; unsigned x;
    volatile LAS unsigned* st;
};

__device__ __forceinline__ XcdBarrier xcd_barrier_post(unsigned* bar, volatile LAS unsigned* st, int wv_) {
    XcdBarrier b; b.bar = bar; b.x = xb_xcc_id(); b.st = st;
    if (TIDX == 0) (void)xb_add(&bar[XB_XCNT(b.x)], 1u);
    return b;
}
__device__ __forceinline__ void xcd_barrier_complete(unsigned* bar, unsigned x, unsigned& nloc, unsigned& nx) {
    const unsigned G = gridDim.x * gridDim.y * gridDim.z;
    unsigned sum, cnt, mine, sp = 0u;
    for (;;) {
        sum = 0u; cnt = 0u; mine = 0u;
#pragma unroll
        for (unsigned j = 0; j < 16; ++j) { const unsigned c = xb_ld(&bar[XB_XCNT(j)]); sum += c; cnt += (c > 0u) ? 1u : 0u; mine = (j == x) ? c : mine; }
        if (sum == G) break;
        __builtin_amdgcn_s_sleep(1);
        if ((++sp & 255u) == 0u) { if (xb_ld(&bar[XB_TMO])) break; if (sp > XB_SPIN_CAP) { atomicAdd(&bar[XB_TMO], 1u); break; } }
    }
    nloc = mine > 0u ? mine : 1u; nx = cnt > 0u ? cnt : 1u;
}

__device__ __forceinline__ void xcd_barrier(const XcdBarrier& b, int wv_) {
    asm volatile("s_waitcnt vmcnt(0)" ::: "memory");
    __syncthreads();
    if (TIDX == 0) {
        unsigned* bar = b.bar;
        __builtin_amdgcn_s_waitcnt(0);
        unsigned nloc = b.st[0], nx = b.st[1];
        if (nloc == 0u) { xcd_barrier_complete(bar, b.x, nloc, nx); b.st[0] = nloc; b.st[1] = nx; }
        const unsigned old = xb_add(&bar[XB_XSUB(b.x)], 1u);
        const unsigned gen = old / nloc;
        if (old + 1u == (gen + 1u) * nloc) {
            __builtin_amdgcn_fence(__ATOMIC_RELEASE, "agent");
            asm volatile("s_waitcnt vmcnt(0)" ::: "memory");
            const unsigned og = xb_add(&bar[XB_TOP], 1u);
            const unsigned tg = og / nx;
            if (og + 1u == (tg + 1u) * nx) xb_add(&bar[XB_TOPGEN], 1u);
            else XB_SPIN(xb_ld(&bar[XB_TOPGEN]) == tg, bar);
            __builtin_amdgcn_fence(__ATOMIC_ACQUIRE, "agent");
            xb_add(&bar[XB_XGEN(b.x)], 1u);
            asm volatile("s_waitcnt vmcnt(0)" ::: "memory");
        } else {
            XB_SPIN(xb_ld(&bar[XB_XGEN(b.x)]) == gen, bar);
            __builtin_amdgcn_fence(__ATOMIC_ACQUIRE, "agent");
            asm volatile("s_waitcnt vmcnt(0)" ::: "memory");
        }
    }
    __syncthreads();
}

constexpr int LDS_BYTES = 147456;
#ifndef NPP_
#define NPP_ 2
#endif
#define GRID_SYNC_CG() do { asm volatile("s_waitcnt vmcnt(0) lgkmcnt(0)" ::: "memory"); grid.sync(); __builtin_amdgcn_fence(__ATOMIC_ACQUIRE, "agent"); asm volatile("s_waitcnt vmcnt(0)" ::: "memory"); } while (0)
constexpr int LDS_ST_OFF = LDS_BYTES - 64;
#define GRID_SYNC() do { ARGS_HERE XcdBarrier b_; b_.bar = (unsigned*)(a.ws + WS_BAR); b_.x = xb_xcc_id(); b_.st = (volatile LAS unsigned*)(ldsl + LDS_ST_OFF); xcd_barrier(b_, wv_); } while (0)
#if defined(SK_GEMM)
#define GEMM_RUN(EpiT, E, Aptr, lda_, Bptr, ldb_, M_, N_, K_) do { (void)(E); } while (0)
#else
#define GEMM_RUN(EpiT, E, Aptr, lda_, Bptr, ldb_, M_, N_, K_) do { pg8::Gemm g_{(Aptr), (Bptr), (lda_), (ldb_), (M_), (N_), (K_)}; pg8::StaticOrder S_; S_.init((M_), (N_), (int)gdim(), (int)bid()); \
        pg8::gemm_phase<EpiT, pg8::StaticOrder, true, true>(ldsl, g_, S_, (E), wv_); } while (0)
#endif
__global__ void __launch_bounds__(512, 2) mega_fwd(Args a_unused) {
    extern __shared__ __attribute__((aligned(16))) unsigned char lds[];
    cg::grid_group grid = cg::this_grid();
    LAS unsigned char* ldsl = (LAS unsigned char*)lds;
    const cargs_t ap = (cargs_t)__builtin_amdgcn_kernarg_segment_ptr();
    const int wv_ = __builtin_amdgcn_readfirstlane((int)threadIdx.x >> 6);
    if (TIDX < 16) ((volatile LAS unsigned*)(ldsl + LDS_ST_OFF))[TIDX] = 0u;
    __syncthreads();
    if (bid() == 0) { ARGS_HERE unsigned* bw = (unsigned*)(a.ws + WS_BAR); for (int i = TIDX; i < XCD_BAR_WORDS; i += 512) bw[i] = 0u; }
#define PH_BEGIN { ARGS_HERE unsigned char* ws = a.ws; unsigned char* dout = (unsigned char*)a.out; (void)ws; (void)dout;
#define PH_END } GRID_SYNC();
#define WSP(T, off) ((T*)(ws + (off)))
#define DOP(T, off) ((T*)(dout + (off)))
#if !defined(SK_INIT)
    init_phase(ap, wv_);
#endif
#pragma unroll 1
    for (int l = 0; l < DEPTH; ++l) {
        if (l == 0) { convert_layer(ap, lnd(0), lds, wv_, 7, 0);
            GRID_SYNC_CG(); ARGS_HERE (void)xcd_barrier_post((unsigned*)(a.ws + WS_BAR), (volatile LAS unsigned*)(ldsl + LDS_ST_OFF), wv_); }
        PH_BEGIN pg8::EpiFfnUp E{WSP(bf16_t, WS_R2), WSP(float, WS_SSQ)}; GEMM_RUN(pg8::EpiFfnUp, E, WSP(bf16_t, WS_HB), DM, WSP(bf16_t, WS_W) + WO_GU1, DM, MROWS, 5632, DM); PH_END
        PH_BEGIN pg8::EpiResid E{WSP(bf16_t, WS_HB), WSP(float, WS_SSQ), 0.5f, 0}; GEMM_RUN(pg8::EpiResid, E, WSP(bf16_t, WS_R2), DFF, WSP(bf16_t, WS_W) + WO_D1, DFF, MROWS, DM, DFF);
            { const int wg0_ = gdim() == 256 ? 4 : 0; const int g_ = ((l + 1 < DEPTH) ? 1 : 0); if (g_) convert_layer(ap, lnd(l + 1), lds, wv_, 1, wg0_); if (l >= 1) convert_layer(ap, lnd(l), lds, wv_, 4, wg0_); } PH_END
        PH_BEGIN pg8::EpiWin1 E{WSP(bf16_t, WS_R1), WSP(bf16_t, WS_R2), WSP(bf16_t, WS_H), WSP(float, WS_SSQ), WSP(float, WS_SSQ2)}; GEMM_RUN(pg8::EpiWin1, E, WSP(bf16_t, WS_HB), DM, WSP(bf16_t, WS_W) + WO_IN1, DM, MROWS, 4864, DM); PH_END
#if !defined(SK_KR)
        kr_rope(ap, wv_);
#endif
        { ARGS_HERE unsigned char* ws = a.ws; unsigned char* dout = (unsigned char*)a.out; pg8::EpiQ E{DOP(bf16_t, DO_Q), WSP(float, WS_SSQ2), WSP(float, WS_ROPE)}; GEMM_RUN(pg8::EpiQ, E, WSP(bf16_t, WS_R1), 768, WSP(bf16_t, WS_W) + WO_UQ, 384, MROWS, 768, 384); }
        { ARGS_HERE unsigned char* ws = a.ws; unsigned char* dout = (unsigned char*)a.out; pg8::EpiKn E{DOP(bf16_t, DO_KN), WSP(float, WS_SSQ2)}; GEMM_RUN(pg8::EpiKn, E, WSP(bf16_t, WS_R1) + 384, 768, WSP(bf16_t, WS_W) + WO_K, 256, MROWS, 512, 256); }
        { ARGS_HERE unsigned char* ws = a.ws; unsigned char* dout = (unsigned char*)a.out; pg8::EpiVt E{DOP(bf16_t, DO_VT), WSP(float, WS_SSQ2)}; GEMM_RUN(pg8::EpiVt, E, WSP(bf16_t, WS_W) + WO_V, 256, WSP(bf16_t, WS_R1) + 384, 768, 512, MROWS, 256); }
#if !defined(SK_H1)
        hgrn_h1(lds, ap, lnd(l), wv_);
#endif
        GRID_SYNC();
#pragma unroll 1
        for (int pp = 0, npp = lnd(NPP_); pp < npp; ++pp) { const int part = (pp == npp - 1) ? 1 : 0;
            if (pp == 0) hgrn_h2(ap, wv_);
            attn_phase(lds, ap, part, wv_);
            if (pp == npp - 1) hgrn_h3(lds, ap, lnd(l), wv_);
            GRID_SYNC(); }
        PH_BEGIN pg8::EpiMerge E{DOP(bf16_t, DO_Q), WSP(bf16_t, WS_H)}; GEMM_RUN(pg8::EpiMerge, E, WSP(bf16_t, WS_R1), DM, WSP(bf16_t, WS_W) + WO_P2, DM, MROWS, 2048, DM); PH_END
        PH_BEGIN pg8::EpiResid E{WSP(bf16_t, WS_HB), WSP(float, WS_SSQ), 1.0f, 1}; GEMM_RUN(pg8::EpiResid, E, DOP(bf16_t, DO_Q), DM, WSP(bf16_t, WS_W) + WO_O, DM, MROWS, DM, DM); PH_END
        PH_BEGIN pg8::EpiFfnUp E{WSP(bf16_t, WS_R2), WSP(float, WS_SSQ)}; GEMM_RUN(pg8::EpiFfnUp, E, WSP(bf16_t, WS_HB), DM, WSP(bf16_t, WS_W) + WO_GU2, DM, MROWS, 5632, DM); PH_END
        PH_BEGIN pg8::EpiResid E{WSP(bf16_t, WS_HB), WSP(float, WS_SSQ), 0.5f, 0}; GEMM_RUN(pg8::EpiResid, E, WSP(bf16_t, WS_R2), DFF, WSP(bf16_t, WS_W) + WO_D2, DFF, MROWS, DM, DFF);
            if (l + 1 < DEPTH) convert_layer(ap, lnd(l + 1), lds, wv_, 2, gdim() == 256 ? 4 : 0); PH_END
    }
#if !defined(SK_FIN)
    final_phase(ap, wv_);
#endif
}

extern "C" void kernel_launch(void* const* d_in, const int* in_sizes, int n_in, void* d_out, int out_size, void* d_ws, size_t ws_size, hipStream_t stream) {
    static int grid_blocks = 0;
    if (grid_blocks == 0) {
        if (n_in != 20 || ws_size < WS_END || out_size != NBATCH * SEQ * DM) { fprintf(stderr, "kernel_launch: unexpected shapes (n_in %d, ws %zu, out %d)\n", n_in, ws_size, out_size); grid_blocks = -1; return; }
        int dev = 0, cus = 0, per_cu = 0;
        (void)hipGetDevice(&dev); (void)hipDeviceGetAttribute(&cus, hipDeviceAttributeMultiprocessorCount, dev);
        if (hipFuncSetAttribute((const void*)mega_fwd, hipFuncAttributeMaxDynamicSharedMemorySize, LDS_BYTES) != hipSuccess) { fprintf(stderr, "kernel_launch: hipFuncSetAttribute failed\n"); grid_blocks = -1; return; }
        if (hipOccupancyMaxActiveBlocksPerMultiprocessor(&per_cu, (const void*)mega_fwd, 512, LDS_BYTES) != hipSuccess || per_cu < 1) { fprintf(stderr, "kernel_launch: occupancy query gave %d\n", per_cu); per_cu = 1; }
        (void)hipGetLastError();
        grid_blocks = cus * per_cu;
    }
    if (grid_blocks < 0) return;
    Args a{};
    for (int i = 0; i < 20; ++i) a.in[i] = (const float*)d_in[i];
    a.out = (float*)d_out; a.ws = (unsigned char*)d_ws;
    void* args[] = {&a};
    hipError_t e = hipLaunchCooperativeKernel((const void*)mega_fwd, dim3(grid_blocks), dim3(512), args, LDS_BYTES, stream);
    if (e != hipSuccess) fprintf(stderr, "cooperative launch failed: %s (grid %d)\n", hipGetErrorString(e), grid_blocks);
}
```
